# Optimizing an MI355X kernel written in HIP

```python
import jax, jax.numpy as jnp
from jax import lax
import numpy as np

D_MODEL = 1024
BATCH = 8
SEQ = 2048
DEPTH = 1

MEM_LEN = 256
ATT_HEADS = 8
ATT_KV_HEADS = 2
ATT_HEAD_DIM = 64
ATT_WIDTH = ATT_HEADS * ATT_HEAD_DIM
ATT_KV_WIDTH = ATT_KV_HEADS * ATT_HEAD_DIM
WINDOW = 128
ATT_BLOCK = 128
ROPE_THETA = 500000.0
ROPE_DIM = ATT_HEAD_DIM // 4
HG_HEADS = 4
HG_DIM = 128
HG_WIDTH = HG_HEADS * HG_DIM
HG_CHUNK = 64
MIX_WIDTH = ATT_WIDTH + HG_WIDTH
IN_COLS = ATT_WIDTH + 2 * ATT_KV_WIDTH + 4 * HG_WIDTH
X_HEADS = 4
X_HEAD_DIM = D_MODEL // X_HEADS
FFN_HIDDEN = -(-8 * D_MODEL // (3 * 256)) * 256
RMS_EPS = 1e-6

kernel_name = 'hymba_swa_sink_hgrn2_xattn_layer'


def rms_norm(x, gain):
    xf = x.astype(jnp.float32)
    y = xf * lax.rsqrt(jnp.mean(xf * xf, axis=-1, keepdims=True) + RMS_EPS)
    return (y * gain.astype(jnp.float32)).astype(x.dtype)


def partial_rotary(x, positions):
    half = ROPE_DIM // 2
    inv_freq = jnp.power(jnp.float32(ROPE_THETA), -jnp.arange(half, dtype=jnp.float32) * (2.0 / ROPE_DIM))
    ang = positions.astype(jnp.float32)[..., None] * inv_freq
    cos = jnp.cos(ang)[:, :, None, :]
    sin = jnp.sin(ang)[:, :, None, :]
    xr = x[..., :ROPE_DIM].astype(jnp.float32)
    x1, x2 = xr[..., :half], xr[..., half:]
    rot = jnp.concatenate([x1 * cos - x2 * sin, x2 * cos + x1 * sin], axis=-1).astype(x.dtype)
    return jnp.concatenate([rot, x[..., ROPE_DIM:]], axis=-1)


def sliding_window_sink_attention(q, k, v, sinks):
    B, S = q.shape[0], q.shape[1]
    nb = S // ATT_BLOCK
    G = ATT_HEADS // ATT_KV_HEADS
    qb = q.reshape(B, nb, ATT_BLOCK, ATT_KV_HEADS, G, ATT_HEAD_DIM)
    pad = ((0, 0), (ATT_BLOCK, 0), (0, 0), (0, 0))
    kp = jnp.pad(k, pad).reshape(B, nb + 1, ATT_BLOCK, ATT_KV_HEADS, ATT_HEAD_DIM)
    vp = jnp.pad(v, pad).reshape(B, nb + 1, ATT_BLOCK, ATT_KV_HEADS, ATT_HEAD_DIM)
    kb = jnp.concatenate([kp[:, :-1], kp[:, 1:]], axis=2)
    vb = jnp.concatenate([vp[:, :-1], vp[:, 1:]], axis=2)
    scores = jnp.einsum('bnqhgd,bnkhd->bnhgqk', qb, kb).astype(jnp.float32) * (ATT_HEAD_DIM ** -0.5)
    q_rel = jnp.arange(ATT_BLOCK)[:, None] + ATT_BLOCK
    k_rel = jnp.arange(2 * ATT_BLOCK)[None, :]
    diff = q_rel - k_rel
    band = (diff >= 0) & (diff < WINDOW)
    key_abs = jnp.arange(nb)[:, None] * ATT_BLOCK - ATT_BLOCK + jnp.arange(2 * ATT_BLOCK)[None, :]
    valid = band[None] & (key_abs >= 0)[:, None, :]
    scores = jnp.where(valid[None, :, None, None], scores, -jnp.inf)
    sink = jnp.broadcast_to(sinks.astype(jnp.float32).reshape(1, 1, ATT_KV_HEADS, G, 1, 1),
                            scores.shape[:-1] + (1,))
    probs = jax.nn.softmax(jnp.concatenate([scores, sink], axis=-1), axis=-1)[..., :-1]
    out = jnp.einsum('bnhgqk,bnkhd->bnqhgd', probs.astype(v.dtype), vb)
    return out.reshape(B, S, ATT_WIDTH)


def hgrn2_chunkwise(q, f_logit, i, lb):
    B, S = q.shape[0], q.shape[1]
    nc = S // HG_CHUNK
    lb = lb.reshape(HG_HEADS, HG_DIM).astype(jnp.float32)
    f = lb + (1.0 - lb) * jax.nn.sigmoid(f_logit.astype(jnp.float32))
    log_f = jnp.log(f)
    key = 1.0 - f
    qf = jax.nn.silu(q.astype(jnp.float32))
    vf = i.astype(jnp.float32)

    def to_chunks(t):
        return t.reshape(B, nc, HG_CHUNK, HG_HEADS, t.shape[-1]).transpose(1, 0, 3, 2, 4)

    causal = jnp.tril(jnp.ones((HG_CHUNK, HG_CHUNK), dtype=bool))

    def step(state, inp):
        qc, kc, vc, gc = inp
        b = jnp.cumsum(gc, axis=2)
        o_inter = jnp.einsum('bhtd,bhde->bhte', qc * jnp.exp(b), state)
        rel = b[:, :, :, None, :] - b[:, :, None, :, :]
        decay = jnp.exp(jnp.where(causal[:, :, None], rel, -jnp.inf))
        scores = jnp.einsum('bhtd,bhsd,bhtsd->bhts', qc, kc, decay)
        o_intra = jnp.einsum('bhts,bhse->bhte', scores, vc)
        b_last = b[:, :, -1:, :]
        k_dec = kc * jnp.exp(b_last - b)
        new_state = jnp.exp(b_last[:, :, 0, :])[..., None] * state + jnp.einsum('bhsd,bhse->bhde', k_dec, vc)
        return new_state, o_inter + o_intra

    s0 = jnp.zeros((B, HG_HEADS, HG_DIM, HG_DIM), jnp.float32)
    _, o = lax.scan(step, s0, (to_chunks(qf), to_chunks(key), to_chunks(vf), to_chunks(log_f)))
    return o.transpose(1, 0, 3, 2, 4).reshape(B, S, HG_HEADS, HG_DIM)


def setup_inputs(seed: int = 0) -> dict:
    key = jax.random.key(seed)
    ks = jax.random.split(key, 20)
    f32 = jnp.float32

    def w(k, shape, fan_in):
        return jax.random.normal(k, shape, f32) * (fan_in ** -0.5)

    def gain(k, shape):
        return 1.0 + 0.02 * jax.random.normal(k, shape, f32)

    x = jax.random.normal(ks[0], (BATCH, SEQ, D_MODEL), f32)
    mem = jax.random.normal(ks[1], (BATCH, MEM_LEN, D_MODEL), f32)
    offset = jax.random.randint(ks[2], (BATCH, 1), 0, 4096, dtype=jnp.int32)
    positions = offset + jnp.arange(SEQ, dtype=jnp.int32)[None, :]
    return {
        'x': x,
        'mem': mem,
        'positions': positions,
        'norm_mix': gain(ks[3], (DEPTH, D_MODEL)),
        'w_in': w(ks[4], (DEPTH, D_MODEL, IN_COLS), D_MODEL),
        'att_sinks': 0.5 * jax.random.normal(ks[5], (DEPTH, ATT_HEADS), f32),
        'att_out_gain': gain(ks[6], (DEPTH, ATT_WIDTH)),
        'hg_lb_logits': 0.5 * jax.random.normal(ks[7], (DEPTH + 1, HG_WIDTH), f32),
        'hg_out_gain': gain(ks[8], (DEPTH, HG_WIDTH)),
        'w_out': w(ks[9], (DEPTH, MIX_WIDTH, D_MODEL), MIX_WIDTH),
        'norm_xattn': gain(ks[10], (DEPTH, D_MODEL)),
        'norm_mem': gain(ks[11], (DEPTH, D_MODEL)),
        'w_xq': w(ks[12], (DEPTH, D_MODEL, D_MODEL), D_MODEL),
        'w_xkv': w(ks[13], (DEPTH, D_MODEL, 2 * D_MODEL), D_MODEL),
        'w_xo': w(ks[14], (DEPTH, D_MODEL, D_MODEL), D_MODEL),
        'norm_ffn': gain(ks[15], (DEPTH, D_MODEL)),
        'w_gate_up': w(ks[16], (DEPTH, D_MODEL, 2 * FFN_HIDDEN), D_MODEL),
        'w_down': w(ks[17], (DEPTH, FFN_HIDDEN, D_MODEL), FFN_HIDDEN),
        'norm_final': gain(ks[18], (D_MODEL,)),
    }


def reference(x, mem, positions, norm_mix, w_in, att_sinks, att_out_gain, hg_lb_logits,
              hg_out_gain, w_out, norm_xattn, norm_mem, w_xq, w_xkv, w_xo, norm_ffn,
              w_gate_up, w_down, norm_final):
    B, S = x.shape[0], x.shape[1]
    M = mem.shape[1]
    lower_bounds = jnp.cumsum(jax.nn.softmax(hg_lb_logits.astype(jnp.float32), axis=0), axis=0)
    split_at = np.cumsum([ATT_WIDTH, ATT_KV_WIDTH, ATT_KV_WIDTH, HG_WIDTH, HG_WIDTH, HG_WIDTH]).tolist()
    for l in range(DEPTH):
        h = rms_norm(x, norm_mix[l])
        proj = h @ w_in[l]
        q_a, k_a, v_a, q_r, f_r, i_r, g_r = jnp.split(proj, split_at, axis=-1)
        q_a = partial_rotary(q_a.reshape(B, S, ATT_HEADS, ATT_HEAD_DIM), positions)
        k_a = partial_rotary(k_a.reshape(B, S, ATT_KV_HEADS, ATT_HEAD_DIM), positions)
        v_a = v_a.reshape(B, S, ATT_KV_HEADS, ATT_HEAD_DIM)
        att = sliding_window_sink_attention(q_a, k_a, v_a, att_sinks[l])
        att = rms_norm(att, att_out_gain[l])

        rec = hgrn2_chunkwise(q_r.reshape(B, S, HG_HEADS, HG_DIM),
                              f_r.reshape(B, S, HG_HEADS, HG_DIM),
                              i_r.reshape(B, S, HG_HEADS, HG_DIM),
                              lower_bounds[l])
        rec = rec * lax.rsqrt(jnp.mean(rec * rec, axis=-1, keepdims=True) + RMS_EPS)
        rec = rec.reshape(B, S, HG_WIDTH) * hg_out_gain[l].astype(jnp.float32)
        rec = (rec * jax.nn.silu(g_r.astype(jnp.float32))).astype(x.dtype)

        x = x + jnp.concatenate([att, rec], axis=-1) @ w_out[l]

        hq = rms_norm(x, norm_xattn[l])
        mn = rms_norm(mem, norm_mem[l])
        xq = (hq @ w_xq[l]).reshape(B, S, X_HEADS, X_HEAD_DIM)
        xk, xv = jnp.split(mn @ w_xkv[l], 2, axis=-1)
        xk = xk.reshape(B, M, X_HEADS, X_HEAD_DIM)
        xv = xv.reshape(B, M, X_HEADS, X_HEAD_DIM)
        xs = jnp.einsum('bqhd,bkhd->bhqk', xq, xk).astype(jnp.float32) * (X_HEAD_DIM ** -0.5)
        xp = jax.nn.softmax(xs, axis=-1).astype(xv.dtype)
        xo = jnp.einsum('bhqk,bkhd->bqhd', xp, xv).reshape(B, S, D_MODEL)
        x = x + xo @ w_xo[l]

        hf = rms_norm(x, norm_ffn[l])
        gate, up = jnp.split(hf @ w_gate_up[l], 2, axis=-1)
        x = x + (jax.nn.silu(gate) * up) @ w_down[l]
    return rms_norm(x, norm_final)
```

```cpp
#include <hip/hip_runtime.h>
#include <hip/hip_cooperative_groups.h>
#include <cstdio>
#include <cstdint>
namespace cg = cooperative_groups;
#ifndef ONE_LAUNCH
#define ONE_LAUNCH 1
#endif
namespace pg8 {
#define PG8_LAS __attribute__((address_space(3)))
typedef unsigned short bf16_t;
typedef short bf16x8 __attribute__((ext_vector_type(8)));
typedef float f32x4 __attribute__((ext_vector_type(4)));
typedef unsigned u32x4 __attribute__((ext_vector_type(4)));
constexpr int BM = 256, BK = 64, HALF = 128, HTB = HALF * BK * 2  , STAGE_BYTES = 8 * HTB, NXCD = 8, WGM = 8;

__host__ __device__ __forceinline__ int lds_byte(int r, int c) { const int st = (r >> 4) * 2 + (c >> 5), rr = r & 15, cc = c & 31, ob = rr * 64 + cc * 2; return st * 1024 + (ob ^ (((ob >> 9) & 1) << 5)); }
__host__ __device__ __forceinline__ void stage_rc(int b, int& R, int& C) { const int st = b / 1024, sb = b % 1024, swz = sb ^ (((sb >> 9) & 1) << 5); R = (st >> 1) * 16 + swz / 64; C = (st & 1) * 32 + (swz % 64) / 2; }
__host__ __device__ __forceinline__ int perm32(int rho) { const int n = rho >> 4, i = rho & 15; return 8 * (i >> 2) + 4 * n + (i & 3); }

struct Unit { int pm, pn; };
struct Gemm { const bf16_t* A; const bf16_t* Bt; int M, N, K; };

struct StaticOrder {
    int nM, nN, nwg, G, c;
    __host__ __device__ void init(int M, int N, int G_, int c_) { nM = M / BM; nN = N / BM; nwg = nM * nN; G = G_; c = c_; }
    __host__ __device__ bool next(int i, Unit& u) const {
        const long L = (long)i * G + c; if (L >= nwg) return false;
        int wgid = (int)L; { const int q = nwg / NXCD, r = nwg % NXCD, xcd = wgid % NXCD, off = wgid / NXCD; wgid = (xcd < r ? xcd * (q + 1) : r * (q + 1) + (xcd - r) * q) + off; }
        const int nig = WGM * nN, gid = wgid / nig, fm = gid * WGM, gsz = (nM - fm) < WGM ? (nM - fm) : WGM;
        u.pm = fm + ((wgid % nig) % gsz); u.pn = (wgid % nig) / gsz; return true;
    }
    __device__ __forceinline__ void a_ready(const Unit&) const {}
    __device__ __forceinline__ void done(const Unit&) const {}
};

__device__ __forceinline__ unsigned cvt_pk_bf16(float lo, float hi) { unsigned r; asm volatile("v_cvt_pk_bf16_f32 %0, %1, %2" : "=v"(r) : "v"(lo), "v"(hi)); return r; }
template <class Epi, class Sched, bool ALIGN_EPI = false, bool SP2 = false>
__device__ __forceinline__ void gemm_phase(PG8_LAS unsigned char* lds, const Gemm g, const Sched& S, const Epi& E) {
    const int tid = threadIdx.x, wid = __builtin_amdgcn_readfirstlane(tid >> 6), lane = tid & 63, wr = wid >> 2, wc = wid & 3, fr = lane & 15, fq = lane >> 4;
    const int K = g.K, nt = K / BK;
    unsigned voffA[2], voffB[2];
#pragma unroll
    for (int i = 0; i < 2; ++i) { int R, C; stage_rc(tid * 16 + i * 8192, R, C); const int Rb = Epi::PERM ? ((R & ~31) + perm32(R & 31)) : R;
        voffA[i] = (unsigned)(R * K + C) * 2u; voffB[i] = (unsigned)(Rb * K + C) * 2u; }
    const size_t kstep = (size_t)(BK * 2);
    const size_t hstep = (size_t)HALF * K * 2;
    const size_t tstep = 2 * hstep;
    const unsigned ldsw = (unsigned)wid * 1024u;
    const int aoff = lds_byte(wr * 64 + fr, fq * 8), boff = lds_byte(wc * 32 + fr, fq * 8);
#define PG8_SA(b, h) (((b) * 2 + (h)) * HTB)
#define PG8_SB(b, h) ((4 + (b) * 2 + (h)) * HTB)
#define PG8_STAGE(bufoff, gbase, voff) do { _Pragma("unroll") for (int _i = 0; _i < 2; ++_i) \
        __builtin_amdgcn_global_load_lds((const unsigned*)((const char*)(gbase) + (voff)[_i]), (PG8_LAS unsigned*)(lds + (bufoff) + ldsw + _i * 8192), 16, 0, 0); } while (0)
#define PG8_LDA(dst, b, h) do { _Pragma("unroll") for (int m = 0; m < 4; ++m) _Pragma("unroll") for (int k = 0; k < 2; ++k) dst[m][k] = *(const PG8_LAS bf16x8*)(lds + PG8_SA(b, h) + aoff + m * 2048 + k * 1024); } while (0)
#define PG8_LDB(dst, b, h) do { _Pragma("unroll") for (int n = 0; n < 2; ++n) _Pragma("unroll") for (int k = 0; k < 2; ++k) dst[n][k] = *(const PG8_LAS bf16x8*)(lds + PG8_SB(b, h) + boff + n * 2048 + k * 1024); } while (0)
#define PG8_MMA(ai, bj, At, Bt) do { __builtin_amdgcn_s_setprio(1); _Pragma("unroll") for (int m = 0; m < 4; ++m) _Pragma("unroll") for (int n = 0; n < 2; ++n) _Pragma("unroll") for (int k = 0; k < 2; ++k) \
        acc[ai][bj][m][n] = __builtin_amdgcn_mfma_f32_16x16x32_bf16(Bt[n][k], At[m][k], acc[ai][bj][m][n], 0, 0, 0); __builtin_amdgcn_s_setprio(0); } while (0)
#define PG8_WAIT_V(n) asm volatile("s_waitcnt vmcnt(" #n ")" ::: "memory")
#define PG8_WAIT_L(n) asm volatile("s_waitcnt lgkmcnt(" #n ")" ::: "memory")
#define PG8_BAR __builtin_amdgcn_s_barrier()
#define PG8_SCHED __builtin_amdgcn_sched_barrier(0)
    Unit cur, nxt; int ui = 0;
    if (!S.next(0, cur)) return;
    f32x4 acc[2][2][4][2];
#pragma unroll
    for (int a = 0; a < 2; ++a)
#pragma unroll
        for (int b = 0; b < 2; ++b)
#pragma unroll
            for (int m = 0; m < 4; ++m)
#pragma unroll
                for (int n = 0; n < 2; ++n) acc[a][b][m][n] = (f32x4){0.f, 0.f, 0.f, 0.f};
    bf16x8 At[4][2], B0[2][2], B1[2][2];
    const char* cA = (const char*)g.A + (size_t)cur.pm * tstep; const char* cB = (const char*)g.Bt + (size_t)cur.pn * tstep;
    S.a_ready(cur);
    if constexpr (SP2) {
        PG8_STAGE(PG8_SB(0, 0), cB, voffB); PG8_STAGE(PG8_SB(0, 1), cB + hstep, voffB); PG8_STAGE(PG8_SA(0, 0), cA, voffA); PG8_STAGE(PG8_SA(0, 1), cA + hstep, voffA);
        if (wr == 1) PG8_BAR;
        PG8_WAIT_V(2); PG8_BAR;
        PG8_STAGE(PG8_SB(1, 0), cB + kstep, voffB); PG8_STAGE(PG8_SA(1, 0), cA + kstep, voffA); PG8_STAGE(PG8_SB(1, 1), cB + hstep + kstep, voffB);
        PG8_WAIT_V(6); PG8_BAR;
    } else {
        PG8_STAGE(PG8_SB(0, 0), cB, voffB); PG8_STAGE(PG8_SA(0, 0), cA, voffA); PG8_STAGE(PG8_SB(0, 1), cB + hstep, voffB); PG8_STAGE(PG8_SA(0, 1), cA + hstep, voffA);
        if (wr == 1) PG8_BAR;
        PG8_WAIT_V(4); PG8_BAR;
        PG8_STAGE(PG8_SB(1, 0), cB + kstep, voffB); PG8_STAGE(PG8_SA(1, 0), cA + kstep, voffA); PG8_STAGE(PG8_SB(1, 1), cB + hstep + kstep, voffB);
        PG8_WAIT_V(6); PG8_BAR;
    }
    for (;;) {
        const bool has_next = S.next(ui + 1, nxt);
        const char* nA = has_next ? (const char*)g.A + (size_t)nxt.pm * tstep : cA; const char* nB = has_next ? (const char*)g.Bt + (size_t)nxt.pn * tstep : cB;
        for (int t = 0; t < nt; t += 2) {
            const bool last = (t == nt - 2);
            const char* a1 = cA + (size_t)(t + 1) * kstep;
            const char* a2 = last ? nA : cA + (size_t)(t + 2) * kstep; const char* b2 = last ? nB : cB + (size_t)(t + 2) * kstep;
            const char* a3 = a2 + kstep; const char* b3 = b2 + kstep;
            if (last && has_next) S.a_ready(nxt);
            if constexpr (SP2) {
            PG8_LDB(B0, 0, 0); PG8_LDB(B1, 0, 1); PG8_SCHED; PG8_LDA(At, 0, 0); PG8_STAGE(PG8_SA(1, 1), a1 + hstep, voffA);
            PG8_WAIT_V(8); PG8_WAIT_L(0); PG8_BAR; PG8_MMA(0, 0, At, B0); PG8_MMA(0, 1, At, B1); PG8_BAR; PG8_SCHED;
            PG8_LDA(At, 0, 1); PG8_STAGE(PG8_SB(0, 0), b2, voffB); PG8_STAGE(PG8_SB(0, 1), b2 + hstep, voffB); PG8_STAGE(PG8_SA(0, 0), a2, voffA);
            PG8_WAIT_V(8); PG8_WAIT_L(0); PG8_BAR; PG8_MMA(1, 0, At, B0); PG8_MMA(1, 1, At, B1); PG8_BAR; PG8_SCHED;
            PG8_LDB(B0, 1, 0); PG8_LDB(B1, 1, 1); PG8_SCHED; PG8_LDA(At, 1, 0); PG8_STAGE(PG8_SA(0, 1), a2 + hstep, voffA);
            PG8_WAIT_V(8); PG8_WAIT_L(0); PG8_BAR; PG8_MMA(0, 0, At, B0); PG8_MMA(0, 1, At, B1); PG8_BAR; PG8_SCHED;
            PG8_LDA(At, 1, 1); PG8_STAGE(PG8_SB(1, 0), b3, voffB); PG8_STAGE(PG8_SB(1, 1), b3 + hstep, voffB); PG8_STAGE(PG8_SA(1, 0), a3, voffA);
            PG8_WAIT_V(8); PG8_WAIT_L(0); PG8_BAR; PG8_MMA(1, 0, At, B0); PG8_MMA(1, 1, At, B1); PG8_BAR; PG8_SCHED;
            } else {
            PG8_LDB(B0, 0, 0); PG8_SCHED; PG8_LDA(At, 0, 0); PG8_STAGE(PG8_SA(1, 1), a1 + hstep, voffA);
            PG8_WAIT_L(8); PG8_BAR; PG8_WAIT_L(0); PG8_MMA(0, 0, At, B0); PG8_BAR; PG8_SCHED;
            PG8_LDB(B1, 0, 1); PG8_STAGE(PG8_SB(0, 0), b2, voffB);
            PG8_BAR; PG8_WAIT_L(0); PG8_MMA(0, 1, At, B1); PG8_BAR;
            PG8_LDA(At, 0, 1); PG8_STAGE(PG8_SA(0, 0), a2, voffA);
            PG8_BAR; PG8_WAIT_L(0); PG8_MMA(1, 0, At, B0); PG8_BAR; PG8_SCHED;
            PG8_STAGE(PG8_SB(0, 1), b2 + hstep, voffB);
            PG8_WAIT_V(6); PG8_BAR; PG8_MMA(1, 1, At, B1); PG8_BAR;
            PG8_LDB(B0, 1, 0); PG8_SCHED; PG8_LDA(At, 1, 0); PG8_STAGE(PG8_SA(0, 1), a2 + hstep, voffA);
            PG8_WAIT_L(8); PG8_BAR; PG8_WAIT_L(0); PG8_MMA(0, 0, At, B0); PG8_BAR; PG8_SCHED;
            PG8_LDB(B1, 1, 1); PG8_STAGE(PG8_SB(1, 0), b3, voffB);
            PG8_BAR; PG8_WAIT_L(0); PG8_MMA(0, 1, At, B1); PG8_BAR;
            PG8_LDA(At, 1, 1); PG8_STAGE(PG8_SA(1, 0), a3, voffA);
            PG8_BAR; PG8_WAIT_L(0); PG8_MMA(1, 0, At, B0); PG8_BAR; PG8_SCHED;
            PG8_STAGE(PG8_SB(1, 1), b3 + hstep, voffB);
            PG8_WAIT_V(6); PG8_BAR; PG8_MMA(1, 1, At, B1); PG8_BAR;
            }
        }
        if constexpr (ALIGN_EPI) { if (wr == 0) PG8_BAR; }
        if constexpr (!Epi::AFTER_DRAIN) { E(acc, cur, wr, wc, fr, fq); S.done(cur); }
        if (!has_next) break;
#pragma unroll
        for (int a = 0; a < 2; ++a)
#pragma unroll
            for (int b = 0; b < 2; ++b)
#pragma unroll
                for (int m = 0; m < 4; ++m)
#pragma unroll
                    for (int n = 0; n < 2; ++n) acc[a][b][m][n] = (f32x4){0.f, 0.f, 0.f, 0.f};
        cur = nxt; cA = nA; cB = nB; ++ui;
        if constexpr (ALIGN_EPI) { if (wr == 1) PG8_BAR; }
    }
    PG8_WAIT_V(0);
    if constexpr (!ALIGN_EPI) { if (wr == 0) PG8_BAR; }
    PG8_BAR;
    if constexpr (Epi::AFTER_DRAIN) { E.fused(acc, cur, wr, wc, fr, fq, lds, wid, lane); S.done(cur); }
#undef PG8_SA
#undef PG8_SB
#undef PG8_STAGE
#undef PG8_LDA
#undef PG8_LDB
#undef PG8_MMA
#undef PG8_WAIT_V
#undef PG8_WAIT_L
#undef PG8_BAR
#undef PG8_SCHED
}
}

#define DI __device__ __forceinline__
#define LAS __attribute__((address_space(3)))
using pg8::bf16_t; using pg8::bf16x8; using pg8::f32x4; using pg8::u32x4; using pg8::Unit;
typedef unsigned u32x2 __attribute__((ext_vector_type(2)));
typedef float f32x2 __attribute__((ext_vector_type(2)));
typedef __bf16 bf16x2_t __attribute__((ext_vector_type(2)));
constexpr int NTOK = 16384, DM = 1024, SEQ = 2048, NMEM = 2048  , INC = 2816, FFH = 2816;
constexpr float EPS = 1e-6f, LOG2E = 1.4426950408889634f;
constexpr size_t MiB = 1u << 20;
constexpr size_t WS_PART1 = 0, WS_PART2 = 1 * MiB, WS_DECAY = 2 * MiB;
constexpr size_t WS_WIN = 3 * MiB;
constexpr size_t WS_WOUT = WS_WIN + 19 * 256 * 1024 * 2;
constexpr size_t WS_WXQ = WS_WOUT + 2 * MiB, WS_WXO = WS_WXQ + 2 * MiB, WS_WGU = WS_WXO + 2 * MiB, WS_WDN = WS_WGU + 11 * MiB;
constexpr size_t WS_XB = 36 * MiB;
constexpr size_t WS_PROJ = 72 * MiB;
constexpr size_t WS_XKV = 160 * MiB;
constexpr size_t WS_MIX = 168 * MiB;
constexpr size_t WS_XVT = 232 * MiB;
constexpr size_t WS_XQ = 200 * MiB;
constexpr int LDS_BYTES = 147456;

struct Params {
    const float *x, *mem; const int* pos;
    const float *norm_mix, *w_in, *sinks, *att_gain, *lb_logits, *hg_gain, *w_out, *norm_xattn, *norm_mem, *w_xq, *w_xkv, *w_xo, *norm_ffn, *w_gu, *w_down, *norm_final;
    float* out; unsigned char* ws; int ph_lo, ph_hi;
};

DI float bf2f(unsigned v) { return __uint_as_float(v << 16); }
DI unsigned pk2(float lo, float hi) { f32x2 v = {lo, hi}; bf16x2_t b = __builtin_convertvector(v, bf16x2_t); return __builtin_bit_cast(unsigned, b); }
DI float lo_f(unsigned w) { return __uint_as_float(w << 16); }
DI float hi_f(unsigned w) { return __uint_as_float(w & 0xffff0000u); }
DI float sigmoidf_(float z) { return __builtin_amdgcn_rcpf(1.f + __expf(-z)); }
DI float wave_sum(float v) {
#pragma unroll
    for (int o = 1; o < 64; o <<= 1) v += __shfl_xor(v, o);
    return v;
}
#define MFMA16(a, b, c) __builtin_amdgcn_mfma_f32_16x16x32_bf16((a), (b), (c), 0, 0, 0)
DI bf16x8 lds_frag(const LAS unsigned char* p) { return *(const LAS bf16x8*)p; }
DI bf16x8 lds_frag2(const LAS unsigned char* p0, const LAS unsigned char* p1) { const u32x2 a = *(const LAS u32x2*)p0, b = *(const LAS u32x2*)p1; u32x4 w = {a.x, a.y, b.x, b.y}; return __builtin_bit_cast(bf16x8, w); }
DI bf16x8 lds_frag_lo(const LAS unsigned char* p0) { const u32x2 a = *(const LAS u32x2*)p0; u32x4 w = {a.x, a.y, 0u, 0u}; return __builtin_bit_cast(bf16x8, w); }
DI bf16x8 pack8(f32x4 a, f32x4 b) { u32x4 w = {pk2(a[0], a[1]), pk2(a[2], a[3]), pk2(b[0], b[1]), pk2(b[2], b[3])}; return __builtin_bit_cast(bf16x8, w); }

struct EpiProj {
    static constexpr bool PERM = true, AFTER_DRAIN = false;
    bf16_t* proj; bf16_t* xkv;
    DI void store_rows(const f32x4 (&acc)[2][2][4][2], bf16_t* p0, size_t ldc) const {
#pragma unroll
        for (int ai = 0; ai < 2; ++ai)
#pragma unroll
            for (int m = 0; m < 4; ++m) { bf16_t* rowp = p0 + (size_t)(ai * 128 + m * 16) * ldc;
#pragma unroll
                for (int bj = 0; bj < 2; ++bj) { const f32x4 v0 = acc[ai][bj][m][0], v1 = acc[ai][bj][m][1];
                    u32x4 w = {pk2(v0[0], v0[1]), pk2(v0[2], v0[3]), pk2(v1[0], v1[1]), pk2(v1[2], v1[3])}; *(u32x4*)(rowp + bj * 128) = w; } }
    }
    DI void operator()(const f32x4 (&acc)[2][2][4][2], const Unit& u, int wr, int wc, int fr, int fq) const {
        const int rl = wr * 64 + fr, cl = wc * 32 + 8 * fq;
        if (u.pm < 64) store_rows(acc, proj + (size_t)(u.pm * 256 + rl) * INC + u.pn * 256 + cl, INC);
        else if (u.pn < 15) store_rows(acc, xkv + (size_t)((u.pm - 64) * 256 + rl) * 2048 + (u.pn - 11) * 256 + cl, 2048);
        else {
            bf16_t* vt = xkv + (WS_XVT - WS_XKV) / 2 + (size_t)((u.pm - 64) * 4 + (u.pn - 15)) * 65536 + (size_t)cl * 256 + rl;
#pragma unroll
            for (int ai = 0; ai < 2; ++ai)
#pragma unroll
                for (int m = 0; m < 4; ++m)
#pragma unroll
                    for (int bj = 0; bj < 2; ++bj)
#pragma unroll
                        for (int n = 0; n < 2; ++n) { const f32x4 v = acc[ai][bj][m][n]; bf16_t* q = vt + (size_t)(bj * 128 + 4 * n) * 256 + ai * 128 + m * 16;
                            const unsigned w0 = pk2(v[0], v[1]), w1 = pk2(v[2], v[3]);
                            q[0] = (bf16_t)w0; q[256] = (bf16_t)(w0 >> 16); q[512] = (bf16_t)w1; q[768] = (bf16_t)(w1 >> 16); }
        }
    }
};
struct EpiRes {
    static constexpr bool PERM = false, AFTER_DRAIN = false;
    const float* base; float* out; bf16_t* xb; float* part;
    DI void operator()(const f32x4 (&acc)[2][2][4][2], const Unit& u, int wr, int wc, int fr, int fq) const {
        const int col0 = u.pn * 256 + wc * 32 + 4 * fq;
#pragma unroll
        for (int ai = 0; ai < 2; ++ai)
#pragma unroll
            for (int m = 0; m < 4; ++m) { const int row = u.pm * 256 + ai * 128 + wr * 64 + m * 16 + fr; const size_t off = (size_t)row * DM + col0; float ss = 0.f;
#pragma unroll
                for (int bj = 0; bj < 2; ++bj)
#pragma unroll
                    for (int n = 0; n < 2; ++n) { const int c = bj * 128 + n * 16; const f32x4 v = *(const f32x4*)(base + off + c) + acc[ai][bj][m][n];
                        *(f32x4*)(out + off + c) = v; ss += (v[0] * v[0] + v[1] * v[1]) + (v[2] * v[2] + v[3] * v[3]);
                        if (xb) { u32x2 w = {pk2(v[0], v[1]), pk2(v[2], v[3])}; *(u32x2*)(xb + off + c) = w; } }
                if (part) { ss += __shfl_xor(ss, 16); ss += __shfl_xor(ss, 32); if (fq == 0) part[(size_t)row * 16 + u.pn * 4 + wc] = ss; } }
    }
};
DI float row_rstd(const float* part, int row) {
    const f32x4* p = (const f32x4*)(part + (size_t)row * 16); const f32x4 a = p[0], b = p[1], c = p[2], d = p[3];
    const float s = ((a[0] + a[1]) + (a[2] + a[3])) + ((b[0] + b[1]) + (b[2] + b[3])) + ((c[0] + c[1]) + (c[2] + c[3])) + ((d[0] + d[1]) + (d[2] + d[3]));
    return __builtin_amdgcn_rsqf(s * (1.0f / DM) + EPS);
}
struct EpiScale {
    static constexpr bool PERM = true, AFTER_DRAIN = false;
    bf16_t* O; const float* part; float cs;
    DI void operator()(const f32x4 (&acc)[2][2][4][2], const Unit& u, int wr, int wc, int fr, int fq) const {
        const int row0 = u.pm * 256 + wr * 64 + fr, col0 = u.pn * 256 + wc * 32 + 8 * fq;
#pragma unroll
        for (int ai = 0; ai < 2; ++ai)
#pragma unroll
            for (int m = 0; m < 4; ++m) { const int row = row0 + ai * 128 + m * 16; const float s = row_rstd(part, row) * cs; bf16_t* rowp = O + (size_t)row * DM + col0;
#pragma unroll
                for (int bj = 0; bj < 2; ++bj) { const f32x4 v0 = acc[ai][bj][m][0] * s, v1 = acc[ai][bj][m][1] * s;
                    u32x4 w = {pk2(v0[0], v0[1]), pk2(v0[2], v0[3]), pk2(v1[0], v1[1]), pk2(v1[2], v1[3])}; *(u32x4*)(rowp + bj * 128) = w; } }
    }
};
struct EpiSwiGLU {
    static constexpr bool PERM = true, AFTER_DRAIN = false;
    bf16_t* H; const float* part;
    DI void operator()(const f32x4 (&acc)[2][2][4][2], const Unit& u, int wr, int wc, int fr, int fq) const {
        const int row0 = u.pm * 256 + wr * 64 + fr, col0 = u.pn * 128 + wc * 32 + 8 * fq;
#pragma unroll
        for (int ai = 0; ai < 2; ++ai)
#pragma unroll
            for (int m = 0; m < 4; ++m) { const int row = row0 + ai * 128 + m * 16; const float s = row_rstd(part, row); unsigned w[4];
#pragma unroll
                for (int n = 0; n < 2; ++n) { const f32x4 g = acc[ai][0][m][n] * s, up = acc[ai][1][m][n] * s; float h[4];
#pragma unroll
                    for (int e = 0; e < 4; ++e) h[e] = g[e] * sigmoidf_(g[e]) * up[e];
                    w[2 * n] = pk2(h[0], h[1]); w[2 * n + 1] = pk2(h[2], h[3]); }
                u32x4 ww = {w[0], w[1], w[2], w[3]}; *(u32x4*)(H + (size_t)row * FFH + col0) = ww; }
    }
};
struct OrderP1 {
    int G, c;
    DI bool next(int i, Unit& u) const { const long L = (long)i * G + c; if (L >= 768) return false; const int x = (int)(L & 7), j = (int)(L >> 3);
        if (j < 88) { u.pm = 8 * x + (j & 7); u.pn = j >> 3; } else { u.pm = 64 + x; u.pn = 11 + (j - 88); } return true; }
    DI void a_ready(const Unit&) const {}
    DI void done(const Unit&) const {}
};

template <int MAP> DI int wmap(int c) { if (MAP == 0) return c; return c < FFH ? ((c >> 7) * 256 + (c & 127)) : (((c - FFH) >> 7) * 256 + 128 + ((c - FFH) & 127)); }
template <int MAP> DI void p0_transpose_item(const float* W, int K, int N, const float* gain, bf16_t* WT, LAS float* scr, int item, int lane) {
    const int nblk = N / 32, kb = item / nblk, nb = item % nblk, k0 = 64 * kb, n0 = 32 * nb;
#pragma unroll 8
    for (int i = 0; i < 32; ++i) { const int kk = 2 * i + (lane >> 5); float v = W[(size_t)(k0 + kk) * N + n0 + (lane & 31)]; if (gain) v *= gain[k0 + kk]; scr[kk * 33 + (lane & 31)] = v; }
    asm volatile("s_waitcnt lgkmcnt(0)" ::: "memory");
    const int c = lane & 7;
#pragma unroll
    for (int j = 0; j < 4; ++j) { const int n = (lane >> 3) + 8 * j; const LAS float* s = scr + (8 * c) * 33 + n;
        u32x4 o = {pk2(s[0 * 33], s[1 * 33]), pk2(s[2 * 33], s[3 * 33]), pk2(s[4 * 33], s[5 * 33]), pk2(s[6 * 33], s[7 * 33])};
        *(u32x4*)(WT + (size_t)wmap<MAP>(n0 + n) * K + k0 + 8 * c) = o; }
    asm volatile("s_waitcnt lgkmcnt(0)" ::: "memory");
}
DI void rms_row_to_bf16(const float* xrow, const float* gain, bf16_t* orow, int lane) {
    const f32x4* xr = (const f32x4*)xrow + lane; const f32x4* gr = (const f32x4*)gain + lane;
    f32x4 v[4]; float s = 0.f;
#pragma unroll
    for (int j = 0; j < 4; ++j) { v[j] = xr[64 * j]; s += (v[j][0] * v[j][0] + v[j][1] * v[j][1]) + (v[j][2] * v[j][2] + v[j][3] * v[j][3]); }
    const float r = __builtin_amdgcn_rsqf(wave_sum(s) * (1.f / DM) + EPS);
    u32x2* o8 = (u32x2*)orow + lane;
#pragma unroll
    for (int j = 0; j < 4; ++j) { const f32x4 g = gr[64 * j]; u32x2 w = {pk2(v[j][0] * r * g[0], v[j][1] * r * g[1]), pk2(v[j][2] * r * g[2], v[j][3] * r * g[3])}; o8[64 * j] = w; }
}
DI void p0_prologue(const Params& p, LAS unsigned char* L) {
    const int tid = threadIdx.x, lane = tid & 63, wave = tid >> 6;
    LAS float* scr = (LAS float*)(L + wave * 16384);
    const int gw = blockIdx.x * 8 + wave, NGW = gridDim.x * 8;
    unsigned char* ws = p.ws;
    constexpr int I_IN = 16 * 88, I_KV = 16 * 64, I_SQ = 16 * 32, I_GU = 16 * 176, I_DN = 44 * 32;
    constexpr int NIT = I_IN + I_KV + 3 * I_SQ + I_GU + I_DN;
    for (int it = gw; it < NIT; it += NGW) {
        int r = it;
        if (r < I_IN) { p0_transpose_item<0>(p.w_in, DM, INC, nullptr, (bf16_t*)(ws + WS_WIN), scr, r, lane); continue; } r -= I_IN;
        if (r < I_KV) { p0_transpose_item<0>(p.w_xkv, DM, 2048, nullptr, (bf16_t*)(ws + WS_WIN) + (size_t)INC * DM, scr, r, lane); continue; } r -= I_KV;
        if (r < I_SQ) { p0_transpose_item<0>(p.w_out, DM, DM, nullptr, (bf16_t*)(ws + WS_WOUT), scr, r, lane); continue; } r -= I_SQ;
        if (r < I_SQ) { p0_transpose_item<0>(p.w_xq, DM, DM, p.norm_xattn, (bf16_t*)(ws + WS_WXQ), scr, r, lane); continue; } r -= I_SQ;
        if (r < I_SQ) { p0_transpose_item<0>(p.w_xo, DM, DM, nullptr, (bf16_t*)(ws + WS_WXO), scr, r, lane); continue; } r -= I_SQ;
        if (r < I_GU) { p0_transpose_item<1>(p.w_gu, DM, 2 * FFH, p.norm_ffn, (bf16_t*)(ws + WS_WGU), scr, r, lane); continue; } r -= I_GU;
        p0_transpose_item<0>(p.w_down, FFH, DM, nullptr, (bf16_t*)(ws + WS_WDN), scr, r, lane);
    }
    bf16_t* xb = (bf16_t*)(ws + WS_XB);
    for (int m = gw; m < NTOK + NMEM; m += NGW) {
        if (m < NTOK) rms_row_to_bf16(p.x + (size_t)m * DM, p.norm_mix, xb + (size_t)m * DM, lane);
        else rms_row_to_bf16(p.mem + (size_t)(m - NTOK) * DM, p.norm_mem, xb + (size_t)m * DM, lane);
    }
}

DI void hgrn_a_unit(const Params& p, LAS unsigned char* L, int unit) {
    const int tid = threadIdx.x, lane = tid & 63, wid = tid >> 6, fr = lane & 15, fq = lane >> 4;
    const int bh = unit >> 5, c = unit & 31, b = bh >> 2, h = bh & 3;
    const size_t tok0 = (size_t)b * SEQ + c * 64;
    const bf16_t* proj = (const bf16_t*)(p.ws + WS_PROJ);
    bf16_t* DT = (bf16_t*)(p.ws + WS_XQ) + (size_t)unit * 16384;
    float* decay = (float*)(p.ws + WS_DECAY) + (size_t)unit * 128;
    LAS float* part = (LAS float*)L;
    LAS unsigned char* KhT = L + 2048;
    LAS unsigned char* VT = L + 2048 + 18432;
    const int d = tid & 127, qt = tid >> 7;
    const float lbv = sigmoidf_(p.lb_logits[h * 128 + d] - p.lb_logits[512 + h * 128 + d]);
    float bc[16], kk[16]; float run = 0.f;
    const bf16_t* fp = proj + (tok0 + 16 * qt) * INC + 1280 + h * 128 + d;
#pragma unroll
    for (int i = 0; i < 16; ++i) { const float z = bf2f(fp[(size_t)i * INC]); const float f = lbv + (1.f - lbv) * sigmoidf_(z); run += __logf(f); bc[i] = run; kk[i] = 1.f - f; }
    part[qt * 128 + d] = run;
    { const bf16_t* vp = proj + (tok0 + 16 * qt) * INC + 1792 + h * 128 + d; unsigned vv[8];
#pragma unroll
      for (int i = 0; i < 8; ++i) vv[i] = (unsigned)vp[(size_t)(2 * i) * INC] | ((unsigned)vp[(size_t)(2 * i + 1) * INC] << 16);
      u32x4 w0 = {vv[0], vv[1], vv[2], vv[3]}, w1 = {vv[4], vv[5], vv[6], vv[7]};
      *(LAS u32x4*)(VT + d * 144 + qt * 32) = w0; *(LAS u32x4*)(VT + d * 144 + qt * 32 + 16) = w1; }
    __syncthreads();
    float off = 0.f, tot = 0.f;
#pragma unroll
    for (int q = 0; q < 4; ++q) { const float v = part[q * 128 + d]; tot += v; if (q < qt) off += v; }
    { unsigned kw[8];
#pragma unroll
      for (int i = 0; i < 8; ++i) { const float a0 = kk[2 * i] * __expf(tot - (off + bc[2 * i])), a1 = kk[2 * i + 1] * __expf(tot - (off + bc[2 * i + 1])); kw[i] = pk2(a0, a1); }
      u32x4 w0 = {kw[0], kw[1], kw[2], kw[3]}, w1 = {kw[4], kw[5], kw[6], kw[7]};
      *(LAS u32x4*)(KhT + d * 144 + qt * 32) = w0; *(LAS u32x4*)(KhT + d * 144 + qt * 32 + 16) = w1; }
    if (qt == 0) decay[d] = __expf(tot);
    __syncthreads();
    bf16x8 a[2];
#pragma unroll
    for (int ks = 0; ks < 2; ++ks) a[ks] = lds_frag(KhT + (16 * wid + fr) * 144 + (32 * ks + 8 * fq) * 2);
#pragma unroll
    for (int et = 0; et < 8; ++et) { f32x4 acc = {0.f, 0.f, 0.f, 0.f};
#pragma unroll
        for (int ks = 0; ks < 2; ++ks) acc = MFMA16(a[ks], lds_frag(VT + (16 * et + fr) * 144 + (32 * ks + 8 * fq) * 2), acc);
        u32x2 w = {pk2(acc[0], acc[1]), pk2(acc[2], acc[3])};
        *(u32x2*)(DT + (size_t)(16 * et + fr) * 128 + 16 * wid + 4 * fq) = w; }
    __syncthreads();
}
DI void hgrn_scan(const Params& p) {
    bf16_t* DT = (bf16_t*)(p.ws + WS_XQ); const float* decay = (const float*)(p.ws + WS_DECAY);
    for (int gid = blockIdx.x * 512 + threadIdx.x; gid < 32 * 4096; gid += gridDim.x * 512) {
        const int bh = gid >> 12, rem = gid & 4095, e = rem >> 5, d4 = (rem & 31) * 4;
        f32x4 S = {0.f, 0.f, 0.f, 0.f};
#pragma unroll 4
        for (int c = 0; c < 32; ++c) { u32x2* q = (u32x2*)(DT + ((size_t)(bh * 32 + c) * 128 + e) * 128 + d4); const u32x2 raw = *q; const f32x4 a = *(const f32x4*)(decay + (size_t)(bh * 32 + c) * 128 + d4);
            u32x2 w = {pk2(S[0], S[1]), pk2(S[2], S[3])}; *q = w;
            S[0] = a[0] * S[0] + lo_f(raw.x); S[1] = a[1] * S[1] + hi_f(raw.x); S[2] = a[2] * S[2] + lo_f(raw.y); S[3] = a[3] * S[3] + hi_f(raw.y); }
    }
}
DI void hgrn_c_unit(const Params& p, LAS unsigned char* L, int unit) {
    const int tid = threadIdx.x, lane = tid & 63, wid = tid >> 6, fr = lane & 15, fq = lane >> 4;
    const int bh = unit >> 5, c = unit & 31, b = bh >> 2, h = bh & 3;
    const size_t tok0 = (size_t)b * SEQ + c * 64;
    const bf16_t* proj = (const bf16_t*)(p.ws + WS_PROJ);
    const bf16_t* Sst = (const bf16_t*)(p.ws + WS_XQ) + (size_t)unit * 16384;
    bf16_t* mix = (bf16_t*)(p.ws + WS_MIX);
    LAS float* part = (LAS float*)L;
    LAS float* exch = (LAS float*)(L + 2048);
    LAS unsigned char* Qh = L + 4096;
    LAS unsigned char* Qc = Qh + 17408;
    LAS unsigned char* Kh = Qc + 17408;
    LAS unsigned char* VT = Kh + 17408;
    LAS unsigned char* ST = VT + 18432;
    const int d = tid & 127, qt = tid >> 7;
    const float lbv = sigmoidf_(p.lb_logits[h * 128 + d] - p.lb_logits[512 + h * 128 + d]);
    float bc[16], kk[16], qs[16]; float run = 0.f;
    { const bf16_t* fp = proj + (tok0 + 16 * qt) * INC + 1280 + h * 128 + d; const bf16_t* qp = proj + (tok0 + 16 * qt) * INC + 768 + h * 128 + d;
#pragma unroll
      for (int i = 0; i < 16; ++i) { const float z = bf2f(fp[(size_t)i * INC]); const float f = lbv + (1.f - lbv) * sigmoidf_(z); run += __logf(f); bc[i] = run; kk[i] = 1.f - f;
          const float qv = bf2f(qp[(size_t)i * INC]); qs[i] = qv * sigmoidf_(qv); } }
    part[qt * 128 + d] = run;
    { const bf16_t* vp = proj + (tok0 + 16 * qt) * INC + 1792 + h * 128 + d; unsigned vv[8];
#pragma unroll
      for (int i = 0; i < 8; ++i) vv[i] = (unsigned)vp[(size_t)(2 * i) * INC] | ((unsigned)vp[(size_t)(2 * i + 1) * INC] << 16);
      u32x4 w0 = {vv[0], vv[1], vv[2], vv[3]}, w1 = {vv[4], vv[5], vv[6], vv[7]};
      *(LAS u32x4*)(VT + d * 144 + qt * 32) = w0; *(LAS u32x4*)(VT + d * 144 + qt * 32 + 16) = w1; }
#pragma unroll
    for (int i = 0; i < 4; ++i) { const int ch = tid + 512 * i, e = ch >> 4, cc = ch & 15; *(LAS u32x4*)(ST + e * 272 + cc * 16) = *(const u32x4*)(Sst + (size_t)e * 128 + cc * 8); }
    __syncthreads();
    { const float p0 = part[d], p1 = part[128 + d], p2 = part[256 + d]; const float bmid = p0 + p1; const float off = qt == 0 ? 0.f : qt == 1 ? p0 : qt == 2 ? p0 + p1 : p0 + p1 + p2;
#pragma unroll
      for (int i = 0; i < 16; ++i) { const float bt = off + bc[i]; const int t = 16 * qt + i;
          *(LAS bf16_t*)(Qh + t * 272 + d * 2) = (bf16_t)pk2(qs[i] * __expf(bt - bmid), 0.f);
          *(LAS bf16_t*)(Qc + t * 272 + d * 2) = (bf16_t)pk2(qs[i] * __expf(bt), 0.f);
          *(LAS bf16_t*)(Kh + t * 272 + d * 2) = (bf16_t)pk2(kk[i] * __expf(bmid - bt), 0.f); } }
    __syncthreads();
    const int tt = wid & 3, eh = wid >> 2;
    bf16x8 qf[4];
#pragma unroll
    for (int ks = 0; ks < 4; ++ks) qf[ks] = lds_frag(Qh + (16 * tt + fr) * 272 + (32 * ks + 8 * fq) * 2);
    f32x4 st[4];
#pragma unroll
    for (int kt = 0; kt < 4; ++kt) { st[kt] = (f32x4){0.f, 0.f, 0.f, 0.f};
        if (kt <= tt) {
#pragma unroll
            for (int ks = 0; ks < 4; ++ks) st[kt] = MFMA16(lds_frag(Kh + (16 * kt + fr) * 272 + (32 * ks + 8 * fq) * 2), qf[ks], st[kt]);
#pragma unroll
            for (int v = 0; v < 4; ++v) if (16 * kt + 4 * fq + v > 16 * tt + fr) st[kt][v] = 0.f;
        } }
    bf16x8 pk[2]; pk[0] = pack8(st[0], st[1]); pk[1] = pack8(st[2], st[3]);
#pragma unroll
    for (int ks = 0; ks < 4; ++ks) qf[ks] = lds_frag(Qc + (16 * tt + fr) * 272 + (32 * ks + 8 * fq) * 2);
    f32x4 o[4]; float ss = 0.f;
#pragma unroll
    for (int et = 0; et < 4; ++et) { const int e = 16 * (4 * eh + et) + fr; f32x4 acc = {0.f, 0.f, 0.f, 0.f};
#pragma unroll
        for (int s2 = 0; s2 < 2; ++s2) if (2 * s2 <= tt) acc = MFMA16(lds_frag2(VT + e * 144 + (32 * s2 + 4 * fq) * 2, VT + e * 144 + (32 * s2 + 16 + 4 * fq) * 2), pk[s2], acc);
#pragma unroll
        for (int ks = 0; ks < 4; ++ks) acc = MFMA16(lds_frag(ST + e * 272 + (32 * ks + 8 * fq) * 2), qf[ks], acc);
        o[et] = acc; ss += (acc[0] * acc[0] + acc[1] * acc[1]) + (acc[2] * acc[2] + acc[3] * acc[3]); }
    ss += __shfl_xor(ss, 16); ss += __shfl_xor(ss, 32);
    if (fq == 0) exch[eh * 64 + 16 * tt + fr] = ss;
    __syncthreads();
    const float rs = __builtin_amdgcn_rsqf((exch[16 * tt + fr] + exch[64 + 16 * tt + fr]) * (1.f / 128.f) + EPS);
    const size_t row = tok0 + 16 * tt + fr;
#pragma unroll
    for (int et = 0; et < 4; ++et) { const int e0 = 16 * (4 * eh + et) + 4 * fq; const u32x2 gw = *(const u32x2*)(proj + row * INC + 2304 + h * 128 + e0); const f32x4 gn = *(const f32x4*)(p.hg_gain + h * 128 + e0);
        const float g0 = lo_f(gw.x), g1 = hi_f(gw.x), g2 = lo_f(gw.y), g3 = hi_f(gw.y);
        u32x2 w = {pk2(o[et][0] * rs * gn[0] * g0 * sigmoidf_(g0), o[et][1] * rs * gn[1] * g1 * sigmoidf_(g1)), pk2(o[et][2] * rs * gn[2] * g2 * sigmoidf_(g2), o[et][3] * rs * gn[3] * g3 * sigmoidf_(g3))};
        *(u32x2*)(mix + row * DM + 512 + h * 128 + e0) = w; }
    __syncthreads();
}

#define ROT_REV(j) ((j) == 0 ? 0.15915494309189535 : (j) == 1 ? 0.03086376340470123 : (j) == 2 ? 0.005985185712713705 : (j) == 3 ? 0.001160663641240061 : (j) == 4 ? 0.00022507907903927653 : (j) == 5 ? 4.364795279280289e-05 : (j) == 6 ? 8.464330808241401e-06 : 1.6414262627950345e-06)
DI void rot_cs(int pos, double rv, float& c, float& s) { double r = (double)pos * rv; r -= __builtin_floor(r); const float f = (float)r; s = __builtin_amdgcn_sinf(f); c = __builtin_amdgcn_cosf(f); }
DI void swa_unit(const Params& p, LAS unsigned char* L, int unit) {
    const int tid = threadIdx.x, lane = tid & 63, wid = tid >> 6, fr = lane & 15, fq = lane >> 4;
    const int b = unit >> 5, j = unit & 31, t0 = 64 * j, ws0 = t0 - 128; const size_t tokbase = (size_t)b * SEQ;
    const bf16_t* proj = (const bf16_t*)(p.ws + WS_PROJ);
    bf16_t* mix = (bf16_t*)(p.ws + WS_MIX);
    LAS unsigned char* Kl = L;
    LAS unsigned char* VT = L + 52224;
    LAS float* exch = (LAS float*)(L + 52224 + 51200);
#pragma unroll 1
    for (int item = tid; item < 1536; item += 512) { const int s = item >> 3, c16 = item & 7, ta = ws0 + s; LAS unsigned char* dst = Kl + s * 272 + c16 * 32;
        u32x4 v0 = {0u, 0u, 0u, 0u}, v1 = {0u, 0u, 0u, 0u};
        if (ta >= 0) { const bf16_t* src = proj + (tokbase + ta) * INC + 512 + c16 * 16; v0 = *(const u32x4*)src; v1 = *(const u32x4*)(src + 8);
            if ((c16 & 3) == 0) { const int pos = p.pos[tokbase + ta]; unsigned o1[4], o2[4];
#pragma unroll
                for (int jj = 0; jj < 4; ++jj) { float c0, s0, c1, s1; rot_cs(pos, ROT_REV(2 * jj), c0, s0); rot_cs(pos, ROT_REV(2 * jj + 1), c1, s1);
                    const float a0 = lo_f(v0[jj]), a1 = hi_f(v0[jj]), b0 = lo_f(v1[jj]), b1 = hi_f(v1[jj]);
                    o1[jj] = pk2(a0 * c0 - b0 * s0, a1 * c1 - b1 * s1); o2[jj] = pk2(b0 * c0 + a0 * s0, b1 * c1 + a1 * s1); }
                v0 = (u32x4){o1[0], o1[1], o1[2], o1[3]}; v1 = (u32x4){o2[0], o2[1], o2[2], o2[3]}; } }
        *(LAS u32x4*)dst = v0; *(LAS u32x4*)(dst + 16) = v1; }
    { const int ch = tid & 127, kq = tid >> 7;
#pragma unroll 1
      for (int g = 0; g < 6; ++g) { unsigned vv[4];
#pragma unroll
          for (int i = 0; i < 4; ++i) { const int ta = ws0 + 48 * kq + 8 * g + 2 * i; unsigned lo = 0u, hi = 0u;
              if (ta >= 0) { lo = proj[(tokbase + ta) * INC + 640 + ch]; hi = proj[(tokbase + ta + 1) * INC + 640 + ch]; }
              vv[i] = lo | (hi << 16); }
          u32x4 w = {vv[0], vv[1], vv[2], vv[3]}; *(LAS u32x4*)(VT + ch * 400 + kq * 96 + g * 16) = w; } }
    __syncthreads();
    const int tt = wid & 3, hk = wid >> 2; const size_t row = tokbase + t0 + 16 * tt + fr;
    float cq[8], sq[8];
    { const int pos = p.pos[row];
#pragma unroll
      for (int jj = 0; jj < 8; ++jj) rot_cs(pos, ROT_REV(jj), cq[jj], sq[jj]); }
    f32x4 o[4][4]; float ss = 0.f;
#pragma unroll
    for (int hh = 0; hh < 4; ++hh) { const int head = 4 * hk + hh;
        bf16x8 qb[2];
#pragma unroll
        for (int ks = 0; ks < 2; ++ks) { const u32x4 raw = *(const u32x4*)(proj + row * INC + head * 64 + 32 * ks + 8 * fq); float q[8];
#pragma unroll
            for (int e = 0; e < 4; ++e) { q[2 * e] = lo_f(raw[e]); q[2 * e + 1] = hi_f(raw[e]); }
            if (ks == 0) {
#pragma unroll
                for (int e = 0; e < 8; ++e) { const float pr = __shfl_xor(q[e], 16); const float r0 = q[e] * cq[e] - pr * sq[e], r1 = q[e] * cq[e] + pr * sq[e]; q[e] = fq == 0 ? r0 : fq == 1 ? r1 : q[e]; } }
            const float sc = 0.125f * LOG2E;
            u32x4 w = {pk2(q[0] * sc, q[1] * sc), pk2(q[2] * sc, q[3] * sc), pk2(q[4] * sc, q[5] * sc), pk2(q[6] * sc, q[7] * sc)}; qb[ks] = __builtin_bit_cast(bf16x8, w); }
        f32x4 st[9];
#pragma unroll
        for (int k9 = 0; k9 < 9; ++k9) { f32x4 acc = {0.f, 0.f, 0.f, 0.f};
#pragma unroll
            for (int ks = 0; ks < 2; ++ks) acc = MFMA16(lds_frag(Kl + (16 * (tt + k9) + fr) * 272 + (hk * 64 + 32 * ks + 8 * fq) * 2), qb[ks], acc);
            st[k9] = acc; }
        const float sinkl = p.sinks[head] * LOG2E; float mx = sinkl;
#pragma unroll
        for (int k9 = 0; k9 < 9; ++k9)
#pragma unroll
            for (int v = 0; v < 4; ++v) { const int s1 = 16 * k9 + 4 * fq + v; const bool ok = (s1 > fr) && (s1 <= fr + 128) && (ws0 + 16 * tt + s1 >= 0);
                st[k9][v] = ok ? st[k9][v] : -INFINITY; mx = fmaxf(mx, st[k9][v]); }
        mx = fmaxf(mx, __shfl_xor(mx, 16)); mx = fmaxf(mx, __shfl_xor(mx, 32));
        float l = 0.f;
#pragma unroll
        for (int k9 = 0; k9 < 9; ++k9)
#pragma unroll
            for (int v = 0; v < 4; ++v) { const float e = __builtin_amdgcn_exp2f(st[k9][v] - mx); st[k9][v] = e; l += e; }
        l += __shfl_xor(l, 16); l += __shfl_xor(l, 32); l += __builtin_amdgcn_exp2f(sinkl - mx);
        const float rl = __builtin_amdgcn_rcpf(l);
        bf16x8 pk[5];
#pragma unroll
        for (int s2 = 0; s2 < 4; ++s2) pk[s2] = pack8(st[2 * s2], st[2 * s2 + 1]);
        pk[4] = pack8(st[8], (f32x4){0.f, 0.f, 0.f, 0.f});
#pragma unroll
        for (int dt = 0; dt < 4; ++dt) { const LAS unsigned char* vr = VT + (hk * 64 + 16 * dt + fr) * 400 + (16 * tt + 4 * fq) * 2; f32x4 acc = {0.f, 0.f, 0.f, 0.f};
#pragma unroll
            for (int s2 = 0; s2 < 4; ++s2) acc = MFMA16(lds_frag2(vr + s2 * 64, vr + s2 * 64 + 32), pk[s2], acc);
            acc = MFMA16(lds_frag_lo(vr + 256), pk[4], acc);
            acc = acc * rl; o[hh][dt] = acc; ss += (acc[0] * acc[0] + acc[1] * acc[1]) + (acc[2] * acc[2] + acc[3] * acc[3]); }
        __builtin_amdgcn_sched_barrier(0); }
    ss += __shfl_xor(ss, 16); ss += __shfl_xor(ss, 32);
    if (fq == 0) exch[hk * 64 + 16 * tt + fr] = ss;
    __syncthreads();
    const float rs = __builtin_amdgcn_rsqf((exch[16 * tt + fr] + exch[64 + 16 * tt + fr]) * (1.f / 512.f) + EPS);
#pragma unroll
    for (int hh = 0; hh < 4; ++hh)
#pragma unroll
        for (int dt = 0; dt < 4; ++dt) { const int ch = (4 * hk + hh) * 64 + 16 * dt + 4 * fq; const f32x4 gn = *(const f32x4*)(p.att_gain + ch); const f32x4 a = o[hh][dt];
            u32x2 w = {pk2(a[0] * rs * gn[0], a[1] * rs * gn[1]), pk2(a[2] * rs * gn[2], a[3] * rs * gn[3])}; *(u32x2*)(mix + row * DM + ch) = w; }
    __syncthreads();
}

DI void xattn_unit(const Params& p, LAS unsigned char* L, int unit) {
    const int tid = threadIdx.x, lane = tid & 63, wid = tid >> 6, fr = lane & 15, fq = lane >> 4;
    const int b = unit >> 6, h = (unit >> 4) & 3, qb = unit & 15;
    const bf16_t* xq = (const bf16_t*)(p.ws + WS_XQ); const bf16_t* xkv = (const bf16_t*)(p.ws + WS_XKV); bf16_t* xo = (bf16_t*)(p.ws + WS_MIX);
    const size_t row = (size_t)b * SEQ + qb * 128 + wid * 16 + fr;
    LAS unsigned char* B0 = L; LAS unsigned char* B1 = L + 67584;
    const bf16_t* kbase = xkv + (size_t)(b * 256) * 2048 + h * 256;
#pragma unroll
    for (int i = 0; i < 16; ++i) { const int ch = tid + 512 * i, key = ch >> 5, cc = ch & 31;
        LAS unsigned char* dst = (key < 128 ? B0 : B1) + (key & 127) * 528 + cc * 16; *(LAS u32x4*)dst = *(const u32x4*)(kbase + (size_t)key * 2048 + cc * 8); }
    bf16x8 qf[8];
#pragma unroll
    for (int ks = 0; ks < 8; ++ks) { const u32x4 raw = *(const u32x4*)(xq + row * DM + h * 256 + 32 * ks + 8 * fq); qf[ks] = __builtin_bit_cast(bf16x8, raw); }
    __syncthreads();
    f32x4 st[16];
#pragma unroll
    for (int kt = 0; kt < 16; ++kt) { const LAS unsigned char* kr = (kt < 8 ? B0 : B1) + (16 * (kt & 7) + fr) * 528 + 8 * fq * 2; f32x4 acc = {0.f, 0.f, 0.f, 0.f};
#pragma unroll
        for (int ks = 0; ks < 8; ++ks) acc = MFMA16(lds_frag(kr + ks * 64), qf[ks], acc);
        st[kt] = acc; __builtin_amdgcn_sched_barrier(0); }
    __syncthreads();
    { const bf16_t* vt = xkv + (WS_XVT - WS_XKV) / 2 + (size_t)(b * 4 + h) * 65536;
#pragma unroll
      for (int i = 0; i < 16; ++i) { const int ch = tid + 512 * i, dd = ch >> 5, cc = ch & 31;
          LAS unsigned char* dst = (dd < 128 ? B0 : B1) + (dd & 127) * 528 + cc * 16; *(LAS u32x4*)dst = *(const u32x4*)(vt + (size_t)dd * 256 + cc * 8); } }
    float mx = -INFINITY;
#pragma unroll
    for (int kt = 0; kt < 16; ++kt)
#pragma unroll
        for (int v = 0; v < 4; ++v) mx = fmaxf(mx, st[kt][v]);
    mx = fmaxf(mx, __shfl_xor(mx, 16)); mx = fmaxf(mx, __shfl_xor(mx, 32));
    float l = 0.f;
#pragma unroll
    for (int kt = 0; kt < 16; ++kt)
#pragma unroll
        for (int v = 0; v < 4; ++v) { const float e = __builtin_amdgcn_exp2f(st[kt][v] - mx); st[kt][v] = e; l += e; }
    l += __shfl_xor(l, 16); l += __shfl_xor(l, 32);
    const float rl = __builtin_amdgcn_rcpf(l);
    bf16x8 pk[8];
#pragma unroll
    for (int s2 = 0; s2 < 8; ++s2) pk[s2] = pack8(st[2 * s2], st[2 * s2 + 1]);
    __syncthreads();
#pragma unroll 1
    for (int hf = 0; hf < 2; ++hf)
#pragma unroll 1
        for (int dg = 0; dg < 2; ++dg) { f32x4 acc[4];
#pragma unroll
            for (int i = 0; i < 4; ++i) acc[i] = (f32x4){0.f, 0.f, 0.f, 0.f};
#pragma unroll
            for (int s2 = 0; s2 < 8; ++s2)
#pragma unroll
                for (int i = 0; i < 4; ++i) { const LAS unsigned char* vr = (hf ? B1 : B0) + (16 * (4 * dg + i) + fr) * 528 + (32 * s2 + 4 * fq) * 2; acc[i] = MFMA16(lds_frag2(vr, vr + 32), pk[s2], acc[i]); }
#pragma unroll
            for (int i = 0; i < 4; ++i) { const f32x4 a = acc[i] * rl; u32x2 w = {pk2(a[0], a[1]), pk2(a[2], a[3])};
                *(u32x2*)(xo + row * DM + h * 256 + hf * 128 + 16 * (4 * dg + i) + 4 * fq) = w; } }
    __syncthreads();
}

DI void final_norm(const Params& p) {
    const int lane = threadIdx.x & 63, wave = threadIdx.x >> 6;
    for (int m = blockIdx.x * 8 + wave; m < NTOK; m += gridDim.x * 8) {
        f32x4* xr = (f32x4*)(p.out + (size_t)m * DM) + lane; const f32x4* gr = (const f32x4*)p.norm_final + lane;
        f32x4 v[4]; float s = 0.f;
#pragma unroll
        for (int j = 0; j < 4; ++j) { v[j] = xr[64 * j]; s += (v[j][0] * v[j][0] + v[j][1] * v[j][1]) + (v[j][2] * v[j][2] + v[j][3] * v[j][3]); }
        const float r = __builtin_amdgcn_rsqf(wave_sum(s) * (1.f / DM) + EPS);
#pragma unroll
        for (int j = 0; j < 4; ++j) xr[64 * j] = v[j] * r * gr[64 * j];
    }
}

constexpr int N_PHASES = 12;
__global__ void __launch_bounds__(512, 2) fwd_kernel(Params p) {
    extern __shared__ __attribute__((aligned(16))) unsigned char lds_raw[];
    LAS unsigned char* L = (LAS unsigned char*)lds_raw;
    cg::grid_group grid = cg::this_grid();
    unsigned char* ws = p.ws;
    const int lo = p.ph_lo, hi = p.ph_hi, G = gridDim.x, bid = blockIdx.x;
#define IN(k) (lo <= (k) && (k) < hi)
#define SEAM(k) do { if (IN(k) && IN((k) + 1)) grid.sync(); } while (0)
    bf16_t* const xb = (bf16_t*)(ws + WS_XB); bf16_t* const proj = (bf16_t*)(ws + WS_PROJ); bf16_t* const mix = (bf16_t*)(ws + WS_MIX); bf16_t* const xq = (bf16_t*)(ws + WS_XQ);
    float* const part1 = (float*)(ws + WS_PART1); float* const part2 = (float*)(ws + WS_PART2);

    if (IN(0)) { p0_prologue(p, L); } SEAM(0);
    if (IN(1)) { pg8::Gemm g{xb, (const bf16_t*)(ws + WS_WIN), NTOK + NMEM, INC + 2048, DM}; OrderP1 S{G, bid}; EpiProj E{proj, (bf16_t*)(ws + WS_XKV)};
        pg8::gemm_phase<EpiProj, OrderP1, true, true>(L, g, S, E); } SEAM(1);
    if (IN(2)) { for (int u = bid; u < 1024; u += G) hgrn_a_unit(p, L, u); } SEAM(2);
    if (IN(3)) { hgrn_scan(p); for (int u = bid; u < 256; u += G) swa_unit(p, L, u); } SEAM(3);
    if (IN(4)) { for (int u = bid; u < 1024; u += G) hgrn_c_unit(p, L, u); } SEAM(4);
    if (IN(5)) { pg8::Gemm g{mix, (const bf16_t*)(ws + WS_WOUT), NTOK, DM, DM}; pg8::StaticOrder S; S.init(NTOK, DM, G, bid); EpiRes E{p.x, p.out, xb, part1};
        pg8::gemm_phase<EpiRes, pg8::StaticOrder, true, true>(L, g, S, E); } SEAM(5);
    if (IN(6)) { pg8::Gemm g{xb, (const bf16_t*)(ws + WS_WXQ), NTOK, DM, DM}; pg8::StaticOrder S; S.init(NTOK, DM, G, bid); EpiScale E{xq, part1, 0.0625f * LOG2E};
        pg8::gemm_phase<EpiScale, pg8::StaticOrder, true, true>(L, g, S, E); } SEAM(6);
    if (IN(7)) { for (int u = bid; u < 512; u += G) xattn_unit(p, L, u); } SEAM(7);
    if (IN(8)) { pg8::Gemm g{mix, (const bf16_t*)(ws + WS_WXO), NTOK, DM, DM}; pg8::StaticOrder S; S.init(NTOK, DM, G, bid); EpiRes E{p.out, p.out, xb, part2};
        pg8::gemm_phase<EpiRes, pg8::StaticOrder, true, true>(L, g, S, E); } SEAM(8);
    if (IN(9)) { pg8::Gemm g{xb, (const bf16_t*)(ws + WS_WGU), NTOK, 2 * FFH, DM}; pg8::StaticOrder S; S.init(NTOK, 2 * FFH, G, bid); EpiSwiGLU E{proj, part2};
        pg8::gemm_phase<EpiSwiGLU, pg8::StaticOrder, true, true>(L, g, S, E); } SEAM(9);
    if (IN(10)) { pg8::Gemm g{proj, (const bf16_t*)(ws + WS_WDN), NTOK, DM, FFH}; pg8::StaticOrder S; S.init(NTOK, DM, G, bid); EpiRes E{p.out, p.out, nullptr, nullptr};
        pg8::gemm_phase<EpiRes, pg8::StaticOrder, true, true>(L, g, S, E); } SEAM(10);
    if (IN(11)) { final_norm(p); }
#undef IN
#undef SEAM
}

extern "C" void kernel_launch(void* const* d_in, const int* in_sizes, int n_in, void* d_out, int out_size, void* d_ws, size_t ws_size, hipStream_t stream) {
    static int grid = 0;
    if (grid == 0) {
        int dev = 0, cus = 0, per_cu = 0;
        if (hipGetDevice(&dev) != hipSuccess || hipDeviceGetAttribute(&cus, hipDeviceAttributeMultiprocessorCount, dev) != hipSuccess) { fprintf(stderr, "kernel_launch: device query failed\n"); grid = -1; return; }
        if (hipFuncSetAttribute((const void*)fwd_kernel, hipFuncAttributeMaxDynamicSharedMemorySize, LDS_BYTES) != hipSuccess) { fprintf(stderr, "kernel_launch: hipFuncSetAttribute failed\n"); grid = -1; return; }
        if (hipOccupancyMaxActiveBlocksPerMultiprocessor(&per_cu, (const void*)fwd_kernel, 512, LDS_BYTES) != hipSuccess || per_cu < 1) { fprintf(stderr, "kernel_launch: occupancy query gave %d\n", per_cu); per_cu = 1; }
        (void)hipGetLastError();
        grid = cus * 1;
        if (ws_size < 236 * MiB) { fprintf(stderr, "kernel_launch: workspace too small (%zu)\n", ws_size); grid = -1; return; }
    }
    if (grid < 0) return;
    Params p{};
    p.x = (const float*)d_in[0]; p.mem = (const float*)d_in[1]; p.pos = (const int*)d_in[2]; p.norm_mix = (const float*)d_in[3]; p.w_in = (const float*)d_in[4];
    p.sinks = (const float*)d_in[5]; p.att_gain = (const float*)d_in[6]; p.lb_logits = (const float*)d_in[7]; p.hg_gain = (const float*)d_in[8]; p.w_out = (const float*)d_in[9];
    p.norm_xattn = (const float*)d_in[10]; p.norm_mem = (const float*)d_in[11]; p.w_xq = (const float*)d_in[12]; p.w_xkv = (const float*)d_in[13]; p.w_xo = (const float*)d_in[14];
    p.norm_ffn = (const float*)d_in[15]; p.w_gu = (const float*)d_in[16]; p.w_down = (const float*)d_in[17]; p.norm_final = (const float*)d_in[18];
    p.out = (float*)d_out; p.ws = (unsigned char*)d_ws;
#if ONE_LAUNCH
    p.ph_lo = 0; p.ph_hi = N_PHASES;
    void* args[] = {&p};
    hipError_t e = hipLaunchCooperativeKernel((const void*)fwd_kernel, dim3(grid), dim3(512), args, LDS_BYTES, stream);
    if (e != hipSuccess) fprintf(stderr, "kernel_launch: cooperative launch failed: %s (grid %d)\n", hipGetErrorString(e), grid);
#else
    for (int k = 0; k < N_PHASES; ++k) { p.ph_lo = k; p.ph_hi = k + 1; hipLaunchKernelGGL(fwd_kernel, dim3(grid), dim3(512), LDS_BYTES, stream, p); }
#endif
}
```

```cpp
#include <hip/hip_runtime.h>
#include <hip/hip_cooperative_groups.h>
#include <cstdio>
#include <cstdint>
namespace cg = cooperative_groups;
#ifndef ONE_LAUNCH
#define ONE_LAUNCH 1
#endif
namespace pg8 {
#define PG8_LAS __attribute__((address_space(3)))
typedef unsigned short bf16_t;
typedef short bf16x8 __attribute__((ext_vector_type(8)));
typedef float f32x4 __attribute__((ext_vector_type(4)));
typedef unsigned u32x4 __attribute__((ext_vector_type(4)));
constexpr int BM = 256, BK = 64, HALF = 128, HTB = HALF * BK * 2  , STAGE_BYTES = 8 * HTB, NXCD = 8, WGM = 8;

__host__ __device__ __forceinline__ int lds_byte(int r, int c) { const int st = (r >> 4) * 2 + (c >> 5), rr = r & 15, cc = c & 31, ob = rr * 64 + cc * 2; return st * 1024 + (ob ^ (((ob >> 9) & 1) << 5)); }
__host__ __device__ __forceinline__ void stage_rc(int b, int& R, int& C) { const int st = b / 1024, sb = b % 1024, swz = sb ^ (((sb >> 9) & 1) << 5); R = (st >> 1) * 16 + swz / 64; C = (st & 1) * 32 + (swz % 64) / 2; }
__host__ __device__ __forceinline__ int perm32(int rho) { const int n = rho >> 4, i = rho & 15; return 8 * (i >> 2) + 4 * n + (i & 3); }

struct Unit { int pm, pn; };
struct Gemm { const bf16_t* A; const bf16_t* Bt; int M, N, K; };

struct StaticOrder {
    int nM, nN, nwg, G, c;
    __host__ __device__ void init(int M, int N, int G_, int c_) { nM = M / BM; nN = N / BM; nwg = nM * nN; G = G_; c = c_; }
    __host__ __device__ bool next(int i, Unit& u) const {
        const long L = (long)i * G + c; if (L >= nwg) return false;
        int wgid = (int)L; { const int q = nwg / NXCD, r = nwg % NXCD, xcd = wgid % NXCD, off = wgid / NXCD; wgid = (xcd < r ? xcd * (q + 1) : r * (q + 1) + (xcd - r) * q) + off; }
        const int nig = WGM * nN, gid = wgid / nig, fm = gid * WGM, gsz = (nM - fm) < WGM ? (nM - fm) : WGM;
        u.pm = fm + ((wgid % nig) % gsz); u.pn = (wgid % nig) / gsz; return true;
    }
    __device__ __forceinline__ void a_ready(const Unit&) const {}
    __device__ __forceinline__ void done(const Unit&) const {}
};

__device__ __forceinline__ unsigned cvt_pk_bf16(float lo, float hi) { unsigned r; asm volatile("v_cvt_pk_bf16_f32 %0, %1, %2" : "=v"(r) : "v"(lo), "v"(hi)); return r; }
template <class Epi, class Sched, bool ALIGN_EPI = false, bool SP2 = false>
__device__ __forceinline__ void gemm_phase(PG8_LAS unsigned char* lds, const Gemm g, const Sched& S, const Epi& E) {
    const int tid = threadIdx.x, wid = __builtin_amdgcn_readfirstlane(tid >> 6), lane = tid & 63, wr = wid >> 2, wc = wid & 3, fr = lane & 15, fq = lane >> 4;
    const int K = g.K, nt = K / BK;
    unsigned voffA[2], voffB[2];
#pragma unroll
    for (int i = 0; i < 2; ++i) { int R, C; stage_rc(tid * 16 + i * 8192, R, C); const int Rb = Epi::PERM ? ((R & ~31) + perm32(R & 31)) : R;
        voffA[i] = (unsigned)(R * K + C) * 2u; voffB[i] = (unsigned)(Rb * K + C) * 2u; }
    const size_t kstep = (size_t)(BK * 2);
    const size_t hstep = (size_t)HALF * K * 2;
    const size_t tstep = 2 * hstep;
    const unsigned ldsw = (unsigned)wid * 1024u;
    const int aoff = lds_byte(wr * 64 + fr, fq * 8), boff = lds_byte(wc * 32 + fr, fq * 8);
#define PG8_SA(b, h) (((b) * 2 + (h)) * HTB)
#define PG8_SB(b, h) ((4 + (b) * 2 + (h)) * HTB)
#define PG8_STAGE(bufoff, gbase, voff) do { _Pragma("unroll") for (int _i = 0; _i < 2; ++_i) \
        __builtin_amdgcn_global_load_lds((const unsigned*)((const char*)(gbase) + (voff)[_i]), (PG8_LAS unsigned*)(lds + (bufoff) + ldsw + _i * 8192), 16, 0, 0); } while (0)
#define PG8_LDA(dst, b, h) do { _Pragma("unroll") for (int m = 0; m < 4; ++m) _Pragma("unroll") for (int k = 0; k < 2; ++k) dst[m][k] = *(const PG8_LAS bf16x8*)(lds + PG8_SA(b, h) + aoff + m * 2048 + k * 1024); } while (0)
#define PG8_LDB(dst, b, h) do { _Pragma("unroll") for (int n = 0; n < 2; ++n) _Pragma("unroll") for (int k = 0; k < 2; ++k) dst[n][k] = *(const PG8_LAS bf16x8*)(lds + PG8_SB(b, h) + boff + n * 2048 + k * 1024); } while (0)
#define PG8_MMA(ai, bj, At, Bt) do { __builtin_amdgcn_s_setprio(1); _Pragma("unroll") for (int m = 0; m < 4; ++m) _Pragma("unroll") for (int n = 0; n < 2; ++n) _Pragma("unroll") for (int k = 0; k < 2; ++k) \
        acc[ai][bj][m][n] = __builtin_amdgcn_mfma_f32_16x16x32_bf16(Bt[n][k], At[m][k], acc[ai][bj][m][n], 0, 0, 0); __builtin_amdgcn_s_setprio(0); } while (0)
#define PG8_WAIT_V(n) asm volatile("s_waitcnt vmcnt(" #n ")" ::: "memory")
#define PG8_WAIT_L(n) asm volatile("s_waitcnt lgkmcnt(" #n ")" ::: "memory")
#define PG8_BAR __builtin_amdgcn_s_barrier()
#define PG8_SCHED __builtin_amdgcn_sched_barrier(0)
    Unit cur, nxt; int ui = 0;
    if (!S.next(0, cur)) return;
    f32x4 acc[2][2][4][2];
#pragma unroll
    for (int a = 0; a < 2; ++a)
#pragma unroll
        for (int b = 0; b < 2; ++b)
#pragma unroll
            for (int m = 0; m < 4; ++m)
#pragma unroll
                for (int n = 0; n < 2; ++n) acc[a][b][m][n] = (f32x4){0.f, 0.f, 0.f, 0.f};
    bf16x8 At[4][2], B0[2][2], B1[2][2];
    const char* cA = (const char*)g.A + (size_t)cur.pm * tstep; const char* cB = (const char*)g.Bt + (size_t)cur.pn * tstep;
    S.a_ready(cur);
    if constexpr (SP2) {
        PG8_STAGE(PG8_SB(0, 0), cB, voffB); PG8_STAGE(PG8_SB(0, 1), cB + hstep, voffB); PG8_STAGE(PG8_SA(0, 0), cA, voffA); PG8_STAGE(PG8_SA(0, 1), cA + hstep, voffA);
        if (wr == 1) PG8_BAR;
        PG8_WAIT_V(2); PG8_BAR;
        PG8_STAGE(PG8_SB(1, 0), cB + kstep, voffB); PG8_STAGE(PG8_SA(1, 0), cA + kstep, voffA); PG8_STAGE(PG8_SB(1, 1), cB + hstep + kstep, voffB);
        PG8_WAIT_V(6); PG8_BAR;
    } else {
        PG8_STAGE(PG8_SB(0, 0), cB, voffB); PG8_STAGE(PG8_SA(0, 0), cA, voffA); PG8_STAGE(PG8_SB(0, 1), cB + hstep, voffB); PG8_STAGE(PG8_SA(0, 1), cA + hstep, voffA);
        if (wr == 1) PG8_BAR;
        PG8_WAIT_V(4); PG8_BAR;
        PG8_STAGE(PG8_SB(1, 0), cB + kstep, voffB); PG8_STAGE(PG8_SA(1, 0), cA + kstep, voffA); PG8_STAGE(PG8_SB(1, 1), cB + hstep + kstep, voffB);
        PG8_WAIT_V(6); PG8_BAR;
    }
    for (;;) {
        const bool has_next = S.next(ui + 1, nxt);
        const char* nA = has_next ? (const char*)g.A + (size_t)nxt.pm * tstep : cA; const char* nB = has_next ? (const char*)g.Bt + (size_t)nxt.pn * tstep : cB;
        for (int t = 0; t < nt; t += 2) {
            const bool last = (t == nt - 2);
            const char* a1 = cA + (size_t)(t + 1) * kstep;
            const char* a2 = last ? nA : cA + (size_t)(t + 2) * kstep; const char* b2 = last ? nB : cB + (size_t)(t + 2) * kstep;
            const char* a3 = a2 + kstep; const char* b3 = b2 + kstep;
            if (last && has_next) S.a_ready(nxt);
            if constexpr (SP2) {
            PG8_LDB(B0, 0, 0); PG8_LDB(B1, 0, 1); PG8_SCHED; PG8_LDA(At, 0, 0); PG8_STAGE(PG8_SA(1, 1), a1 + hstep, voffA);
            PG8_WAIT_V(8); PG8_WAIT_L(0); PG8_BAR; PG8_MMA(0, 0, At, B0); PG8_MMA(0, 1, At, B1); PG8_BAR; PG8_SCHED;
            PG8_LDA(At, 0, 1); PG8_STAGE(PG8_SB(0, 0), b2, voffB); PG8_STAGE(PG8_SB(0, 1), b2 + hstep, voffB); PG8_STAGE(PG8_SA(0, 0), a2, voffA);
            PG8_WAIT_V(8); PG8_WAIT_L(0); PG8_BAR; PG8_MMA(1, 0, At, B0); PG8_MMA(1, 1, At, B1); PG8_BAR; PG8_SCHED;
            PG8_LDB(B0, 1, 0); PG8_LDB(B1, 1, 1); PG8_SCHED; PG8_LDA(At, 1, 0); PG8_STAGE(PG8_SA(0, 1), a2 + hstep, voffA);
            PG8_WAIT_V(8); PG8_WAIT_L(0); PG8_BAR; PG8_MMA(0, 0, At, B0); PG8_MMA(0, 1, At, B1); PG8_BAR; PG8_SCHED;
            PG8_LDA(At, 1, 1); PG8_STAGE(PG8_SB(1, 0), b3, voffB); PG8_STAGE(PG8_SB(1, 1), b3 + hstep, voffB); PG8_STAGE(PG8_SA(1, 0), a3, voffA);
            PG8_WAIT_V(8); PG8_WAIT_L(0); PG8_BAR; PG8_MMA(1, 0, At, B0); PG8_MMA(1, 1, At, B1); PG8_BAR; PG8_SCHED;
            } else {
            PG8_LDB(B0, 0, 0); PG8_SCHED; PG8_LDA(At, 0, 0); PG8_STAGE(PG8_SA(1, 1), a1 + hstep, voffA);
            PG8_WAIT_L(8); PG8_BAR; PG8_WAIT_L(0); PG8_MMA(0, 0, At, B0); PG8_BAR; PG8_SCHED;
            PG8_LDB(B1, 0, 1); PG8_STAGE(PG8_SB(0, 0), b2, voffB);
            PG8_BAR; PG8_WAIT_L(0); PG8_MMA(0, 1, At, B1); PG8_BAR;
            PG8_LDA(At, 0, 1); PG8_STAGE(PG8_SA(0, 0), a2, voffA);
            PG8_BAR; PG8_WAIT_L(0); PG8_MMA(1, 0, At, B0); PG8_BAR; PG8_SCHED;
            PG8_STAGE(PG8_SB(0, 1), b2 + hstep, voffB);
            PG8_WAIT_V(6); PG8_BAR; PG8_MMA(1, 1, At, B1); PG8_BAR;
            PG8_LDB(B0, 1, 0); PG8_SCHED; PG8_LDA(At, 1, 0); PG8_STAGE(PG8_SA(0, 1), a2 + hstep, voffA);
            PG8_WAIT_L(8); PG8_BAR; PG8_WAIT_L(0); PG8_MMA(0, 0, At, B0); PG8_BAR; PG8_SCHED;
            PG8_LDB(B1, 1, 1); PG8_STAGE(PG8_SB(1, 0), b3, voffB);
            PG8_BAR; PG8_WAIT_L(0); PG8_MMA(0, 1, At, B1); PG8_BAR;
            PG8_LDA(At, 1, 1); PG8_STAGE(PG8_SA(1, 0), a3, voffA);
            PG8_BAR; PG8_WAIT_L(0); PG8_MMA(1, 0, At, B0); PG8_BAR; PG8_SCHED;
            PG8_STAGE(PG8_SB(1, 1), b3 + hstep, voffB);
            PG8_WAIT_V(6); PG8_BAR; PG8_MMA(1, 1, At, B1); PG8_BAR;
            }
        }
        if constexpr (ALIGN_EPI) { if (wr == 0) PG8_BAR; }
        if constexpr (!Epi::AFTER_DRAIN) { E(acc, cur, wr, wc, fr, fq); S.done(cur); }
        if (!has_next) break;
#pragma unroll
        for (int a = 0; a < 2; ++a)
#pragma unroll
            for (int b = 0; b < 2; ++b)
#pragma unroll
                for (int m = 0; m < 4; ++m)
#pragma unroll
                    for (int n = 0; n < 2; ++n) acc[a][b][m][n] = (f32x4){0.f, 0.f, 0.f, 0.f};
        cur = nxt; cA = nA; cB = nB; ++ui;
        if constexpr (ALIGN_EPI) { if (wr == 1) PG8_BAR; }
    }
    PG8_WAIT_V(0);
    if constexpr (!ALIGN_EPI) { if (wr == 0) PG8_BAR; }
    PG8_BAR;
    if constexpr (Epi::AFTER_DRAIN) { E.fused(acc, cur, wr, wc, fr, fq, lds, wid, lane); S.done(cur); }
#undef PG8_SA
#undef PG8_SB
#undef PG8_STAGE
#undef PG8_LDA
#undef PG8_LDB
#undef PG8_MMA
#undef PG8_WAIT_V
#undef PG8_WAIT_L
#undef PG8_BAR
#undef PG8_SCHED
}
}

#define DI __device__ __forceinline__
#define LAS __attribute__((address_space(3)))
using pg8::bf16_t; using pg8::bf16x8; using pg8::f32x4; using pg8::u32x4; using pg8::Unit;
typedef unsigned u32x2 __attribute__((ext_vector_type(2)));
typedef float f32x2 __attribute__((ext_vector_type(2)));
typedef __bf16 bf16x2_t __attribute__((ext_vector_type(2)));
constexpr int NTOK = 16384, DM = 1024, SEQ = 2048, NMEM = 2048  , INC = 2816, FFH = 2816;
constexpr float EPS = 1e-6f, LOG2E = 1.4426950408889634f;
constexpr size_t MiB = 1u << 20;
constexpr size_t WS_PART1 = 0, WS_PART2 = 1 * MiB, WS_DECAY = 2 * MiB;
constexpr size_t WS_WIN = 3 * MiB;
constexpr size_t WS_WOUT = WS_WIN + 19 * 256 * 1024 * 2;
constexpr size_t WS_WXQ = WS_WOUT + 2 * MiB, WS_WXO = WS_WXQ + 2 * MiB, WS_WGU = WS_WXO + 2 * MiB, WS_WDN = WS_WGU + 11 * MiB;
constexpr size_t WS_XB = 36 * MiB;
constexpr size_t WS_PROJ = 72 * MiB;
constexpr size_t WS_XKV = 160 * MiB;
constexpr size_t WS_MIX = 168 * MiB;
constexpr size_t WS_XVT = 232 * MiB;
constexpr size_t WS_XQ = 200 * MiB;
constexpr int LDS_BYTES = 147456;

struct Params {
    const float *x, *mem; const int* pos;
    const float *norm_mix, *w_in, *sinks, *att_gain, *lb_logits, *hg_gain, *w_out, *norm_xattn, *norm_mem, *w_xq, *w_xkv, *w_xo, *norm_ffn, *w_gu, *w_down, *norm_final;
    float* out; unsigned char* ws; int ph_lo, ph_hi;
};

DI float bf2f(unsigned v) { return __uint_as_float(v << 16); }
DI unsigned pk2(float lo, float hi) { f32x2 v = {lo, hi}; bf16x2_t b = __builtin_convertvector(v, bf16x2_t); return __builtin_bit_cast(unsigned, b); }
DI float lo_f(unsigned w) { return __uint_as_float(w << 16); }
DI float hi_f(unsigned w) { return __uint_as_float(w & 0xffff0000u); }
DI float sigmoidf_(float z) { return __builtin_amdgcn_rcpf(1.f + __expf(-z)); }
DI float wave_sum(float v) {
#pragma unroll
    for (int o = 1; o < 64; o <<= 1) v += __shfl_xor(v, o);
    return v;
}
#define MFMA16(a, b, c) __builtin_amdgcn_mfma_f32_16x16x32_bf16((a), (b), (c), 0, 0, 0)
DI bf16x8 lds_frag(const LAS unsigned char* p) { return *(const LAS bf16x8*)p; }
DI bf16x8 lds_frag2(const LAS unsigned char* p0, const LAS unsigned char* p1) { const u32x2 a = *(const LAS u32x2*)p0, b = *(const LAS u32x2*)p1; u32x4 w = {a.x, a.y, b.x, b.y}; return __builtin_bit_cast(bf16x8, w); }
DI bf16x8 lds_frag_lo(const LAS unsigned char* p0) { const u32x2 a = *(const LAS u32x2*)p0; u32x4 w = {a.x, a.y, 0u, 0u}; return __builtin_bit_cast(bf16x8, w); }
DI bf16x8 pack8(f32x4 a, f32x4 b) { u32x4 w = {pk2(a[0], a[1]), pk2(a[2], a[3]), pk2(b[0], b[1]), pk2(b[2], b[3])}; return __builtin_bit_cast(bf16x8, w); }

struct EpiProj {
    static constexpr bool PERM = true, AFTER_DRAIN = false;
    bf16_t* proj; bf16_t* xkv;
    DI void store_rows(const f32x4 (&acc)[2][2][4][2], bf16_t* p0, size_t ldc) const {
#pragma unroll
        for (int ai = 0; ai < 2; ++ai)
#pragma unroll
            for (int m = 0; m < 4; ++m) { bf16_t* rowp = p0 + (size_t)(ai * 128 + m * 16) * ldc;
#pragma unroll
                for (int bj = 0; bj < 2; ++bj) { const f32x4 v0 = acc[ai][bj][m][0], v1 = acc[ai][bj][m][1];
                    u32x4 w = {pk2(v0[0], v0[1]), pk2(v0[2], v0[3]), pk2(v1[0], v1[1]), pk2(v1[2], v1[3])}; *(u32x4*)(rowp + bj * 128) = w; } }
    }
    DI void operator()(const f32x4 (&acc)[2][2][4][2], const Unit& u, int wr, int wc, int fr, int fq) const {
        const int rl = wr * 64 + fr, cl = wc * 32 + 8 * fq;
        if (u.pm < 64) store_rows(acc, proj + (size_t)(u.pm * 256 + rl) * INC + u.pn * 256 + cl, INC);
        else if (u.pn < 15) store_rows(acc, xkv + (size_t)((u.pm - 64) * 256 + rl) * 2048 + (u.pn - 11) * 256 + cl, 2048);
        else {
            bf16_t* vt = xkv + (WS_XVT - WS_XKV) / 2 + (size_t)((u.pm - 64) * 4 + (u.pn - 15)) * 65536 + (size_t)cl * 256 + rl;
#pragma unroll
            for (int ai = 0; ai < 2; ++ai)
#pragma unroll
                for (int m = 0; m < 4; ++m)
#pragma unroll
                    for (int bj = 0; bj < 2; ++bj)
#pragma unroll
                        for (int n = 0; n < 2; ++n) { const f32x4 v = acc[ai][bj][m][n]; bf16_t* q = vt + (size_t)(bj * 128 + 4 * n) * 256 + ai * 128 + m * 16;
                            const unsigned w0 = pk2(v[0], v[1]), w1 = pk2(v[2], v[3]);
                            q[0] = (bf16_t)w0; q[256] = (bf16_t)(w0 >> 16); q[512] = (bf16_t)w1; q[768] = (bf16_t)(w1 >> 16); }
        }
    }
};
template <int MODE> struct EpiRes {
    static constexpr bool PERM = true, AFTER_DRAIN = false;
    const void* base; void* out; float* part;
    DI void operator()(const f32x4 (&acc)[2][2][4][2], const Unit& u, int wr, int wc, int fr, int fq) const {
        const int col0 = u.pn * 256 + wc * 32 + 8 * fq;
#pragma unroll
        for (int ai = 0; ai < 2; ++ai)
#pragma unroll
            for (int m = 0; m < 4; ++m) { const int row = u.pm * 256 + ai * 128 + wr * 64 + m * 16 + fr; const size_t off = (size_t)row * DM + col0; float ss = 0.f;
#pragma unroll
                for (int bj = 0; bj < 2; ++bj) { f32x4 v0, v1;
                    if (MODE == 0) { const float* bp = (const float*)base + off + bj * 128; v0 = *(const f32x4*)bp; v1 = *(const f32x4*)(bp + 4); }
                    else { const u32x4 r = *(const u32x4*)((const bf16_t*)base + off + bj * 128); v0 = (f32x4){lo_f(r[0]), hi_f(r[0]), lo_f(r[1]), hi_f(r[1])}; v1 = (f32x4){lo_f(r[2]), hi_f(r[2]), lo_f(r[3]), hi_f(r[3])}; }
                    v0 = v0 + acc[ai][bj][m][0]; v1 = v1 + acc[ai][bj][m][1];
                    if (MODE == 2) { float* op = (float*)out + off + bj * 128; *(f32x4*)op = v0; *(f32x4*)(op + 4) = v1; }
                    else { u32x4 w = {pk2(v0[0], v0[1]), pk2(v0[2], v0[3]), pk2(v1[0], v1[1]), pk2(v1[2], v1[3])}; *(u32x4*)((bf16_t*)out + off + bj * 128) = w;
                        const float a0 = lo_f(w[0]), a1 = hi_f(w[0]), a2 = lo_f(w[1]), a3 = hi_f(w[1]), a4 = lo_f(w[2]), a5 = hi_f(w[2]), a6 = lo_f(w[3]), a7 = hi_f(w[3]);
                        ss += ((a0 * a0 + a1 * a1) + (a2 * a2 + a3 * a3)) + ((a4 * a4 + a5 * a5) + (a6 * a6 + a7 * a7)); } }
                if (MODE != 2) { ss += __shfl_xor(ss, 16); ss += __shfl_xor(ss, 32); if (fq == 0) part[(size_t)row * 16 + u.pn * 4 + wc] = ss; } }
    }
};
DI float row_rstd(const float* part, int row) {
    const f32x4* p = (const f32x4*)(part + (size_t)row * 16); const f32x4 a = p[0], b = p[1], c = p[2], d = p[3];
    const float s = ((a[0] + a[1]) + (a[2] + a[3])) + ((b[0] + b[1]) + (b[2] + b[3])) + ((c[0] + c[1]) + (c[2] + c[3])) + ((d[0] + d[1]) + (d[2] + d[3]));
    return __builtin_amdgcn_rsqf(s * (1.0f / DM) + EPS);
}
struct EpiScale {
    static constexpr bool PERM = true, AFTER_DRAIN = false;
    bf16_t* O; const float* part; float cs;
    DI void operator()(const f32x4 (&acc)[2][2][4][2], const Unit& u, int wr, int wc, int fr, int fq) const {
        const int row0 = u.pm * 256 + wr * 64 + fr, col0 = u.pn * 256 + wc * 32 + 8 * fq;
#pragma unroll
        for (int ai = 0; ai < 2; ++ai)
#pragma unroll
            for (int m = 0; m < 4; ++m) { const int row = row0 + ai * 128 + m * 16; const float s = row_rstd(part, row) * cs; bf16_t* rowp = O + (size_t)row * DM + col0;
#pragma unroll
                for (int bj = 0; bj < 2; ++bj) { const f32x4 v0 = acc[ai][bj][m][0] * s, v1 = acc[ai][bj][m][1] * s;
                    u32x4 w = {pk2(v0[0], v0[1]), pk2(v0[2], v0[3]), pk2(v1[0], v1[1]), pk2(v1[2], v1[3])}; *(u32x4*)(rowp + bj * 128) = w; } }
    }
};
struct EpiSwiGLU {
    static constexpr bool PERM = true, AFTER_DRAIN = false;
    bf16_t* H; const float* part;
    DI void operator()(const f32x4 (&acc)[2][2][4][2], const Unit& u, int wr, int wc, int fr, int fq) const {
        const int row0 = u.pm * 256 + wr * 64 + fr, col0 = u.pn * 128 + wc * 32 + 8 * fq;
#pragma unroll
        for (int ai = 0; ai < 2; ++ai)
#pragma unroll
            for (int m = 0; m < 4; ++m) { const int row = row0 + ai * 128 + m * 16; const float s = row_rstd(part, row); unsigned w[4];
#pragma unroll
                for (int n = 0; n < 2; ++n) { const f32x4 g = acc[ai][0][m][n] * s, up = acc[ai][1][m][n] * s; float h[4];
#pragma unroll
                    for (int e = 0; e < 4; ++e) h[e] = g[e] * sigmoidf_(g[e]) * up[e];
                    w[2 * n] = pk2(h[0], h[1]); w[2 * n + 1] = pk2(h[2], h[3]); }
                u32x4 ww = {w[0], w[1], w[2], w[3]}; *(u32x4*)(H + (size_t)row * FFH + col0) = ww; }
    }
};
struct OrderP1 {
    int G, c;
    DI bool next(int i, Unit& u) const { const long L = (long)i * G + c; if (L >= 768) return false; const int x = (int)(L & 7), j = (int)(L >> 3);
        if (j < 88) { u.pm = 8 * x + (j & 7); u.pn = j >> 3; } else { u.pm = 64 + x; u.pn = 11 + (j - 88); } return true; }
    DI void a_ready(const Unit&) const {}
    DI void done(const Unit&) const {}
};

template <int MAP> DI int wmap(int c) { if (MAP == 0) return c; return c < FFH ? ((c >> 7) * 256 + (c & 127)) : (((c - FFH) >> 7) * 256 + 128 + ((c - FFH) & 127)); }
template <int MAP> DI void p0_transpose_item(const float* W, int K, int N, const float* gain, bf16_t* WT, LAS float* scr, int item, int lane) {
    const int nblk = N / 32, kb = item / nblk, nb = item % nblk, k0 = 64 * kb, n0 = 32 * nb;
    float v[32];
    const float* wp = W + (size_t)(k0 + (lane >> 5)) * N + n0 + (lane & 31);
#pragma unroll
    for (int i = 0; i < 32; ++i) v[i] = wp[(size_t)(2 * i) * N];
    if (gain) {
#pragma unroll
        for (int i = 0; i < 32; ++i) v[i] *= gain[k0 + 2 * i + (lane >> 5)];
    }
#pragma unroll
    for (int i = 0; i < 32; ++i) scr[(2 * i + (lane >> 5)) * 33 + (lane & 31)] = v[i];
    asm volatile("s_waitcnt lgkmcnt(0)" ::: "memory");
    const int c = lane & 7;
#pragma unroll
    for (int j = 0; j < 4; ++j) { const int n = (lane >> 3) + 8 * j; const LAS float* s = scr + (8 * c) * 33 + n;
        u32x4 o = {pk2(s[0 * 33], s[1 * 33]), pk2(s[2 * 33], s[3 * 33]), pk2(s[4 * 33], s[5 * 33]), pk2(s[6 * 33], s[7 * 33])};
        *(u32x4*)(WT + (size_t)wmap<MAP>(n0 + n) * K + k0 + 8 * c) = o; }
    asm volatile("s_waitcnt lgkmcnt(0)" ::: "memory");
}
DI void rms_rows2_to_bf16(const float* x0, const float* x1, const float* gain, bf16_t* o0, bf16_t* o1, int lane) {
    const f32x4* xa = (const f32x4*)x0 + lane; const f32x4* xc = (const f32x4*)x1 + lane; const f32x4* gr = (const f32x4*)gain + lane;
    f32x4 v[4], w[4]; float s = 0.f, t = 0.f;
#pragma unroll
    for (int j = 0; j < 4; ++j) { v[j] = xa[64 * j]; w[j] = xc[64 * j]; }
#pragma unroll
    for (int j = 0; j < 4; ++j) { s += (v[j][0] * v[j][0] + v[j][1] * v[j][1]) + (v[j][2] * v[j][2] + v[j][3] * v[j][3]); t += (w[j][0] * w[j][0] + w[j][1] * w[j][1]) + (w[j][2] * w[j][2] + w[j][3] * w[j][3]); }
    const float r = __builtin_amdgcn_rsqf(wave_sum(s) * (1.f / DM) + EPS), q = __builtin_amdgcn_rsqf(wave_sum(t) * (1.f / DM) + EPS);
    u32x2* p8 = (u32x2*)o0 + lane; u32x2* q8 = (u32x2*)o1 + lane;
#pragma unroll
    for (int j = 0; j < 4; ++j) { const f32x4 g = gr[64 * j];
        u32x2 a = {pk2(v[j][0] * r * g[0], v[j][1] * r * g[1]), pk2(v[j][2] * r * g[2], v[j][3] * r * g[3])}; p8[64 * j] = a;
        u32x2 c = {pk2(w[j][0] * q * g[0], w[j][1] * q * g[1]), pk2(w[j][2] * q * g[2], w[j][3] * q * g[3])}; q8[64 * j] = c; }
}
DI void p0_prologue(const Params& p, LAS unsigned char* L) {
    const int tid = threadIdx.x, lane = tid & 63, wave = tid >> 6;
    LAS float* scr = (LAS float*)(L + wave * 16384);
    const int gw = blockIdx.x * 8 + wave, NGW = gridDim.x * 8;
    unsigned char* ws = p.ws;
    constexpr int I_IN = 16 * 88, I_KV = 16 * 64, I_SQ = 16 * 32, I_GU = 16 * 176, I_DN = 44 * 32;
    constexpr int NIT = I_IN + I_KV + 3 * I_SQ + I_GU + I_DN;
    for (int it = gw; it < NIT; it += NGW) {
        int r = it;
        if (r < I_IN) { p0_transpose_item<0>(p.w_in, DM, INC, nullptr, (bf16_t*)(ws + WS_WIN), scr, r, lane); continue; } r -= I_IN;
        if (r < I_KV) { p0_transpose_item<0>(p.w_xkv, DM, 2048, nullptr, (bf16_t*)(ws + WS_WIN) + (size_t)INC * DM, scr, r, lane); continue; } r -= I_KV;
        if (r < I_SQ) { p0_transpose_item<0>(p.w_out, DM, DM, nullptr, (bf16_t*)(ws + WS_WOUT), scr, r, lane); continue; } r -= I_SQ;
        if (r < I_SQ) { p0_transpose_item<0>(p.w_xq, DM, DM, p.norm_xattn, (bf16_t*)(ws + WS_WXQ), scr, r, lane); continue; } r -= I_SQ;
        if (r < I_SQ) { p0_transpose_item<0>(p.w_xo, DM, DM, nullptr, (bf16_t*)(ws + WS_WXO), scr, r, lane); continue; } r -= I_SQ;
        if (r < I_GU) { p0_transpose_item<1>(p.w_gu, DM, 2 * FFH, p.norm_ffn, (bf16_t*)(ws + WS_WGU), scr, r, lane); continue; } r -= I_GU;
        p0_transpose_item<0>(p.w_down, FFH, DM, nullptr, (bf16_t*)(ws + WS_WDN), scr, r, lane);
    }
    bf16_t* xb = (bf16_t*)(ws + WS_XB);
    for (int m = 2 * gw; m < NTOK + NMEM; m += 2 * NGW) {
        if (m < NTOK) rms_rows2_to_bf16(p.x + (size_t)m * DM, p.x + (size_t)(m + 1) * DM, p.norm_mix, xb + (size_t)m * DM, xb + (size_t)(m + 1) * DM, lane);
        else rms_rows2_to_bf16(p.mem + (size_t)(m - NTOK) * DM, p.mem + (size_t)(m + 1 - NTOK) * DM, p.norm_mem, xb + (size_t)m * DM, xb + (size_t)(m + 1) * DM, lane);
    }
}

DI void hgrn_a_unit(const Params& p, LAS unsigned char* L, int unit) {
    const int tid = threadIdx.x, lane = tid & 63, wid = tid >> 6, fr = lane & 15, fq = lane >> 4;
    const int bh = unit >> 5, c = unit & 31, b = bh >> 2, h = bh & 3;
    const size_t tok0 = (size_t)b * SEQ + c * 64;
    const bf16_t* proj = (const bf16_t*)(p.ws + WS_PROJ);
    bf16_t* DT = (bf16_t*)(p.ws + WS_XQ) + (size_t)unit * 16384;
    float* decay = (float*)(p.ws + WS_DECAY) + (size_t)unit * 128;
    LAS float* part = (LAS float*)L;
    LAS unsigned char* KhT = L + 2048;
    LAS unsigned char* VT = L + 2048 + 18432;
    const int d = tid & 127, qt = tid >> 7;
    const float lbv = sigmoidf_(p.lb_logits[h * 128 + d] - p.lb_logits[512 + h * 128 + d]);
    float bc[16], kk[16]; float run = 0.f;
    const bf16_t* fp = proj + (tok0 + 16 * qt) * INC + 1280 + h * 128 + d;
#pragma unroll
    for (int i = 0; i < 16; ++i) { const float z = bf2f(fp[(size_t)i * INC]); const float f = lbv + (1.f - lbv) * sigmoidf_(z); run += __logf(f); bc[i] = run; kk[i] = 1.f - f; }
    part[qt * 128 + d] = run;
    { const bf16_t* vp = proj + (tok0 + 16 * qt) * INC + 1792 + h * 128 + d; unsigned vv[8];
#pragma unroll
      for (int i = 0; i < 8; ++i) vv[i] = (unsigned)vp[(size_t)(2 * i) * INC] | ((unsigned)vp[(size_t)(2 * i + 1) * INC] << 16);
      u32x4 w0 = {vv[0], vv[1], vv[2], vv[3]}, w1 = {vv[4], vv[5], vv[6], vv[7]};
      *(LAS u32x4*)(VT + d * 144 + qt * 32) = w0; *(LAS u32x4*)(VT + d * 144 + qt * 32 + 16) = w1; }
    __syncthreads();
    float off = 0.f, tot = 0.f;
#pragma unroll
    for (int q = 0; q < 4; ++q) { const float v = part[q * 128 + d]; tot += v; if (q < qt) off += v; }
    { unsigned kw[8];
#pragma unroll
      for (int i = 0; i < 8; ++i) { const float a0 = kk[2 * i] * __expf(tot - (off + bc[2 * i])), a1 = kk[2 * i + 1] * __expf(tot - (off + bc[2 * i + 1])); kw[i] = pk2(a0, a1); }
      u32x4 w0 = {kw[0], kw[1], kw[2], kw[3]}, w1 = {kw[4], kw[5], kw[6], kw[7]};
      *(LAS u32x4*)(KhT + d * 144 + qt * 32) = w0; *(LAS u32x4*)(KhT + d * 144 + qt * 32 + 16) = w1; }
    if (qt == 0) decay[d] = __expf(tot);
    __syncthreads();
    bf16x8 a[2];
#pragma unroll
    for (int ks = 0; ks < 2; ++ks) a[ks] = lds_frag(KhT + (16 * wid + fr) * 144 + (32 * ks + 8 * fq) * 2);
#pragma unroll
    for (int et = 0; et < 8; ++et) { f32x4 acc = {0.f, 0.f, 0.f, 0.f};
#pragma unroll
        for (int ks = 0; ks < 2; ++ks) acc = MFMA16(a[ks], lds_frag(VT + (16 * et + fr) * 144 + (32 * ks + 8 * fq) * 2), acc);
        u32x2 w = {pk2(acc[0], acc[1]), pk2(acc[2], acc[3])};
        *(u32x2*)(DT + (size_t)(16 * et + fr) * 128 + 16 * wid + 4 * fq) = w; }
    __syncthreads();
}
DI void hgrn_scan(const Params& p) {
    bf16_t* DT = (bf16_t*)(p.ws + WS_XQ); const float* decay = (const float*)(p.ws + WS_DECAY);
    for (int gid = blockIdx.x * 512 + threadIdx.x; gid < 32 * 4096; gid += gridDim.x * 512) {
        const int bh = gid >> 12, rem = gid & 4095, e = rem >> 5, d4 = (rem & 31) * 4;
        f32x4 S = {0.f, 0.f, 0.f, 0.f};
#pragma unroll 4
        for (int c = 0; c < 32; ++c) { u32x2* q = (u32x2*)(DT + ((size_t)(bh * 32 + c) * 128 + e) * 128 + d4); const u32x2 raw = *q; const f32x4 a = *(const f32x4*)(decay + (size_t)(bh * 32 + c) * 128 + d4);
            u32x2 w = {pk2(S[0], S[1]), pk2(S[2], S[3])}; *q = w;
            S[0] = a[0] * S[0] + lo_f(raw.x); S[1] = a[1] * S[1] + hi_f(raw.x); S[2] = a[2] * S[2] + lo_f(raw.y); S[3] = a[3] * S[3] + hi_f(raw.y); }
    }
}
DI void hgrn_c_unit(const Params& p, LAS unsigned char* L, int unit) {
    const int tid = threadIdx.x, lane = tid & 63, wid = tid >> 6, fr = lane & 15, fq = lane >> 4;
    const int bh = unit >> 5, c = unit & 31, b = bh >> 2, h = bh & 3;
    const size_t tok0 = (size_t)b * SEQ + c * 64;
    const bf16_t* proj = (const bf16_t*)(p.ws + WS_PROJ);
    const bf16_t* Sst = (const bf16_t*)(p.ws + WS_XQ) + (size_t)unit * 16384;
    bf16_t* mix = (bf16_t*)(p.ws + WS_MIX);
    LAS float* part = (LAS float*)L;
    LAS float* exch = (LAS float*)(L + 2048);
    LAS unsigned char* Qh = L + 4096;
    LAS unsigned char* Qc = Qh + 17408;
    LAS unsigned char* Kh = Qc + 17408;
    LAS unsigned char* VT = Kh + 17408;
    LAS unsigned char* ST = VT + 18432;
    const int d = tid & 127, qt = tid >> 7;
    const float lbv = sigmoidf_(p.lb_logits[h * 128 + d] - p.lb_logits[512 + h * 128 + d]);
    float bc[16], kk[16], qs[16]; float run = 0.f;
    { const bf16_t* fp = proj + (tok0 + 16 * qt) * INC + 1280 + h * 128 + d; const bf16_t* qp = proj + (tok0 + 16 * qt) * INC + 768 + h * 128 + d;
#pragma unroll
      for (int i = 0; i < 16; ++i) { const float z = bf2f(fp[(size_t)i * INC]); const float f = lbv + (1.f - lbv) * sigmoidf_(z); run += __logf(f); bc[i] = run; kk[i] = 1.f - f;
          const float qv = bf2f(qp[(size_t)i * INC]); qs[i] = qv * sigmoidf_(qv); } }
    part[qt * 128 + d] = run;
    { const bf16_t* vp = proj + (tok0 + 16 * qt) * INC + 1792 + h * 128 + d; unsigned vv[8];
#pragma unroll
      for (int i = 0; i < 8; ++i) vv[i] = (unsigned)vp[(size_t)(2 * i) * INC] | ((unsigned)vp[(size_t)(2 * i + 1) * INC] << 16);
      u32x4 w0 = {vv[0], vv[1], vv[2], vv[3]}, w1 = {vv[4], vv[5], vv[6], vv[7]};
      *(LAS u32x4*)(VT + d * 144 + qt * 32) = w0; *(LAS u32x4*)(VT + d * 144 + qt * 32 + 16) = w1; }
#pragma unroll
    for (int i = 0; i < 4; ++i) { const int ch = tid + 512 * i, e = ch >> 4, cc = ch & 15; *(LAS u32x4*)(ST + e * 272 + cc * 16) = *(const u32x4*)(Sst + (size_t)e * 128 + cc * 8); }
    __syncthreads();
    { const float p0 = part[d], p1 = part[128 + d], p2 = part[256 + d]; const float bmid = p0 + p1; const float off = qt == 0 ? 0.f : qt == 1 ? p0 : qt == 2 ? p0 + p1 : p0 + p1 + p2;
#pragma unroll
      for (int i = 0; i < 16; ++i) { const float bt = off + bc[i]; const int t = 16 * qt + i;
          *(LAS bf16_t*)(Qh + t * 272 + d * 2) = (bf16_t)pk2(qs[i] * __expf(bt - bmid), 0.f);
          *(LAS bf16_t*)(Qc + t * 272 + d * 2) = (bf16_t)pk2(qs[i] * __expf(bt), 0.f);
          *(LAS bf16_t*)(Kh + t * 272 + d * 2) = (bf16_t)pk2(kk[i] * __expf(bmid - bt), 0.f); } }
    __syncthreads();
    const int tt = wid & 3, eh = wid >> 2;
    bf16x8 qf[4];
#pragma unroll
    for (int ks = 0; ks < 4; ++ks) qf[ks] = lds_frag(Qh + (16 * tt + fr) * 272 + (32 * ks + 8 * fq) * 2);
    f32x4 st[4];
#pragma unroll
    for (int kt = 0; kt < 4; ++kt) { st[kt] = (f32x4){0.f, 0.f, 0.f, 0.f};
        if (kt <= tt) {
#pragma unroll
            for (int ks = 0; ks < 4; ++ks) st[kt] = MFMA16(lds_frag(Kh + (16 * kt + fr) * 272 + (32 * ks + 8 * fq) * 2), qf[ks], st[kt]);
#pragma unroll
            for (int v = 0; v < 4; ++v) if (16 * kt + 4 * fq + v > 16 * tt + fr) st[kt][v] = 0.f;
        } }
    bf16x8 pk[2]; pk[0] = pack8(st[0], st[1]); pk[1] = pack8(st[2], st[3]);
#pragma unroll
    for (int ks = 0; ks < 4; ++ks) qf[ks] = lds_frag(Qc + (16 * tt + fr) * 272 + (32 * ks + 8 * fq) * 2);
    f32x4 o[4]; float ss = 0.f;
#pragma unroll
    for (int et = 0; et < 4; ++et) { const int e = 16 * (4 * eh + et) + fr; f32x4 acc = {0.f, 0.f, 0.f, 0.f};
#pragma unroll
        for (int s2 = 0; s2 < 2; ++s2) if (2 * s2 <= tt) acc = MFMA16(lds_frag2(VT + e * 144 + (32 * s2 + 4 * fq) * 2, VT + e * 144 + (32 * s2 + 16 + 4 * fq) * 2), pk[s2], acc);
#pragma unroll
        for (int ks = 0; ks < 4; ++ks) acc = MFMA16(lds_frag(ST + e * 272 + (32 * ks + 8 * fq) * 2), qf[ks], acc);
        o[et] = acc; ss += (acc[0] * acc[0] + acc[1] * acc[1]) + (acc[2] * acc[2] + acc[3] * acc[3]); }
    ss += __shfl_xor(ss, 16); ss += __shfl_xor(ss, 32);
    if (fq == 0) exch[eh * 64 + 16 * tt + fr] = ss;
    __syncthreads();
    const float rs = __builtin_amdgcn_rsqf((exch[16 * tt + fr] + exch[64 + 16 * tt + fr]) * (1.f / 128.f) + EPS);
    const size_t row = tok0 + 16 * tt + fr;
#pragma unroll
    for (int et = 0; et < 4; ++et) { const int e0 = 16 * (4 * eh + et) + 4 * fq; const u32x2 gw = *(const u32x2*)(proj + row * INC + 2304 + h * 128 + e0); const f32x4 gn = *(const f32x4*)(p.hg_gain + h * 128 + e0);
        const float g0 = lo_f(gw.x), g1 = hi_f(gw.x), g2 = lo_f(gw.y), g3 = hi_f(gw.y);
        u32x2 w = {pk2(o[et][0] * rs * gn[0] * g0 * sigmoidf_(g0), o[et][1] * rs * gn[1] * g1 * sigmoidf_(g1)), pk2(o[et][2] * rs * gn[2] * g2 * sigmoidf_(g2), o[et][3] * rs * gn[3] * g3 * sigmoidf_(g3))};
        *(u32x2*)(mix + row * DM + 512 + h * 128 + e0) = w; }
    __syncthreads();
}

#define ROT_REV(j) ((j) == 0 ? 0.15915494309189535 : (j) == 1 ? 0.03086376340470123 : (j) == 2 ? 0.005985185712713705 : (j) == 3 ? 0.001160663641240061 : (j) == 4 ? 0.00022507907903927653 : (j) == 5 ? 4.364795279280289e-05 : (j) == 6 ? 8.464330808241401e-06 : 1.6414262627950345e-06)
DI void rot_cs(int pos, double rv, float& c, float& s) { double r = (double)pos * rv; r -= __builtin_floor(r); const float f = (float)r; s = __builtin_amdgcn_sinf(f); c = __builtin_amdgcn_cosf(f); }
DI void swa_unit(const Params& p, LAS unsigned char* L, int unit) {
    const int tid = threadIdx.x, lane = tid & 63, wid = tid >> 6, fr = lane & 15, fq = lane >> 4;
    const int b = unit >> 5, j = unit & 31, t0 = 64 * j, ws0 = t0 - 128; const size_t tokbase = (size_t)b * SEQ;
    const bf16_t* proj = (const bf16_t*)(p.ws + WS_PROJ);
    bf16_t* mix = (bf16_t*)(p.ws + WS_MIX);
    LAS unsigned char* Kl = L;
    LAS unsigned char* VT = L + 52224;
    LAS float* exch = (LAS float*)(L + 52224 + 51200);
#pragma unroll 1
    for (int item = tid; item < 1536; item += 512) { const int s = item >> 3, c16 = item & 7, ta = ws0 + s; LAS unsigned char* dst = Kl + s * 272 + c16 * 32;
        u32x4 v0 = {0u, 0u, 0u, 0u}, v1 = {0u, 0u, 0u, 0u};
        if (ta >= 0) { const bf16_t* src = proj + (tokbase + ta) * INC + 512 + c16 * 16; v0 = *(const u32x4*)src; v1 = *(const u32x4*)(src + 8);
            if ((c16 & 3) == 0) { const int pos = p.pos[tokbase + ta]; unsigned o1[4], o2[4];
#pragma unroll
                for (int jj = 0; jj < 4; ++jj) { float c0, s0, c1, s1; rot_cs(pos, ROT_REV(2 * jj), c0, s0); rot_cs(pos, ROT_REV(2 * jj + 1), c1, s1);
                    const float a0 = lo_f(v0[jj]), a1 = hi_f(v0[jj]), b0 = lo_f(v1[jj]), b1 = hi_f(v1[jj]);
                    o1[jj] = pk2(a0 * c0 - b0 * s0, a1 * c1 - b1 * s1); o2[jj] = pk2(b0 * c0 + a0 * s0, b1 * c1 + a1 * s1); }
                v0 = (u32x4){o1[0], o1[1], o1[2], o1[3]}; v1 = (u32x4){o2[0], o2[1], o2[2], o2[3]}; } }
        *(LAS u32x4*)dst = v0; *(LAS u32x4*)(dst + 16) = v1; }
    { const int ch = tid & 127, kq = tid >> 7;
#pragma unroll 1
      for (int g = 0; g < 6; ++g) { unsigned vv[4];
#pragma unroll
          for (int i = 0; i < 4; ++i) { const int ta = ws0 + 48 * kq + 8 * g + 2 * i; unsigned lo = 0u, hi = 0u;
              if (ta >= 0) { lo = proj[(tokbase + ta) * INC + 640 + ch]; hi = proj[(tokbase + ta + 1) * INC + 640 + ch]; }
              vv[i] = lo | (hi << 16); }
          u32x4 w = {vv[0], vv[1], vv[2], vv[3]}; *(LAS u32x4*)(VT + ch * 400 + kq * 96 + g * 16) = w; } }
    __syncthreads();
    const int tt = wid & 3, hk = wid >> 2; const size_t row = tokbase + t0 + 16 * tt + fr;
    float cq[8], sq[8];
    { const int pos = p.pos[row];
#pragma unroll
      for (int jj = 0; jj < 8; ++jj) rot_cs(pos, ROT_REV(jj), cq[jj], sq[jj]); }
    f32x4 o[4][4]; float ss = 0.f;
#pragma unroll
    for (int hh = 0; hh < 4; ++hh) { const int head = 4 * hk + hh;
        bf16x8 qb[2];
#pragma unroll
        for (int ks = 0; ks < 2; ++ks) { const u32x4 raw = *(const u32x4*)(proj + row * INC + head * 64 + 32 * ks + 8 * fq); float q[8];
#pragma unroll
            for (int e = 0; e < 4; ++e) { q[2 * e] = lo_f(raw[e]); q[2 * e + 1] = hi_f(raw[e]); }
            if (ks == 0) {
#pragma unroll
                for (int e = 0; e < 8; ++e) { const float pr = __shfl_xor(q[e], 16); const float r0 = q[e] * cq[e] - pr * sq[e], r1 = q[e] * cq[e] + pr * sq[e]; q[e] = fq == 0 ? r0 : fq == 1 ? r1 : q[e]; } }
            const float sc = 0.125f * LOG2E;
            u32x4 w = {pk2(q[0] * sc, q[1] * sc), pk2(q[2] * sc, q[3] * sc), pk2(q[4] * sc, q[5] * sc), pk2(q[6] * sc, q[7] * sc)}; qb[ks] = __builtin_bit_cast(bf16x8, w); }
        f32x4 st[9];
#pragma unroll
        for (int k9 = 0; k9 < 9; ++k9) { f32x4 acc = {0.f, 0.f, 0.f, 0.f};
#pragma unroll
            for (int ks = 0; ks < 2; ++ks) acc = MFMA16(lds_frag(Kl + (16 * (tt + k9) + fr) * 272 + (hk * 64 + 32 * ks + 8 * fq) * 2), qb[ks], acc);
            st[k9] = acc; }
        const float sinkl = p.sinks[head] * LOG2E; float mx = sinkl;
#pragma unroll
        for (int k9 = 0; k9 < 9; ++k9)
#pragma unroll
            for (int v = 0; v < 4; ++v) { const int s1 = 16 * k9 + 4 * fq + v; const bool ok = (s1 > fr) && (s1 <= fr + 128) && (ws0 + 16 * tt + s1 >= 0);
                st[k9][v] = ok ? st[k9][v] : -INFINITY; mx = fmaxf(mx, st[k9][v]); }
        mx = fmaxf(mx, __shfl_xor(mx, 16)); mx = fmaxf(mx, __shfl_xor(mx, 32));
        float l = 0.f;
#pragma unroll
        for (int k9 = 0; k9 < 9; ++k9)
#pragma unroll
            for (int v = 0; v < 4; ++v) { const float e = __builtin_amdgcn_exp2f(st[k9][v] - mx); st[k9][v] = e; l += e; }
        l += __shfl_xor(l, 16); l += __shfl_xor(l, 32); l += __builtin_amdgcn_exp2f(sinkl - mx);
        const float rl = __builtin_amdgcn_rcpf(l);
        bf16x8 pk[5];
#pragma unroll
        for (int s2 = 0; s2 < 4; ++s2) pk[s2] = pack8(st[2 * s2], st[2 * s2 + 1]);
        pk[4] = pack8(st[8], (f32x4){0.f, 0.f, 0.f, 0.f});
#pragma unroll
        for (int dt = 0; dt < 4; ++dt) { const LAS unsigned char* vr = VT + (hk * 64 + 16 * dt + fr) * 400 + (16 * tt + 4 * fq) * 2; f32x4 acc = {0.f, 0.f, 0.f, 0.f};
#pragma unroll
            for (int s2 = 0; s2 < 4; ++s2) acc = MFMA16(lds_frag2(vr + s2 * 64, vr + s2 * 64 + 32), pk[s2], acc);
            acc = MFMA16(lds_frag_lo(vr + 256), pk[4], acc);
            acc = acc * rl; o[hh][dt] = acc; ss += (acc[0] * acc[0] + acc[1] * acc[1]) + (acc[2] * acc[2] + acc[3] * acc[3]); }
        __builtin_amdgcn_sched_barrier(0); }
    ss += __shfl_xor(ss, 16); ss += __shfl_xor(ss, 32);
    if (fq == 0) exch[hk * 64 + 16 * tt + fr] = ss;
    __syncthreads();
    const float rs = __builtin_amdgcn_rsqf((exch[16 * tt + fr] + exch[64 + 16 * tt + fr]) * (1.f / 512.f) + EPS);
#pragma unroll
    for (int hh = 0; hh < 4; ++hh)
#pragma unroll
        for (int dt = 0; dt < 4; ++dt) { const int ch = (4 * hk + hh) * 64 + 16 * dt + 4 * fq; const f32x4 gn = *(const f32x4*)(p.att_gain + ch); const f32x4 a = o[hh][dt];
            u32x2 w = {pk2(a[0] * rs * gn[0], a[1] * rs * gn[1]), pk2(a[2] * rs * gn[2], a[3] * rs * gn[3])}; *(u32x2*)(mix + row * DM + ch) = w; }
    __syncthreads();
}

DI void xattn_unit(const Params& p, LAS unsigned char* L, int unit) {
    const int tid = threadIdx.x, lane = tid & 63, wid = tid >> 6, fr = lane & 15, fq = lane >> 4;
    const int b = unit >> 5, h = (unit >> 3) & 3, qb = unit & 7;
    const bf16_t* xq = (const bf16_t*)(p.ws + WS_XQ); const bf16_t* xkv = (const bf16_t*)(p.ws + WS_XKV); bf16_t* xo = (bf16_t*)(p.ws + WS_MIX);
    const size_t row0 = (size_t)b * SEQ + qb * 256 + wid * 32 + fr;
    LAS unsigned char* B0 = L; LAS unsigned char* B1 = L + 67584;
    const bf16_t* kbase = xkv + (size_t)(b * 256) * 2048 + h * 256;
    const bf16_t* vt = xkv + (WS_XVT - WS_XKV) / 2 + (size_t)(b * 4 + h) * 65536;
    { u32x4 kreg[16];
#pragma unroll
      for (int i = 0; i < 16; ++i) { const int ch = tid + 512 * i, key = ch >> 5, cc = ch & 31; kreg[i] = *(const u32x4*)(kbase + (size_t)key * 2048 + cc * 8); }
#pragma unroll
      for (int i = 0; i < 16; ++i) { const int ch = tid + 512 * i, key = ch >> 5, cc = ch & 31; *(LAS u32x4*)((key < 128 ? B0 : B1) + (key & 127) * 528 + cc * 16) = kreg[i]; } }
    u32x4 vreg[8];
#pragma unroll
    for (int i = 0; i < 8; ++i) { const int ch = tid + 512 * i, dd = ch >> 5, cc = ch & 31; vreg[i] = *(const u32x4*)(vt + (size_t)dd * 256 + cc * 8); }
    __syncthreads();
    bf16x8 pk[2][8]; float rl[2];
#pragma unroll
    for (int t = 0; t < 2; ++t) {
        bf16x8 qf[8];
#pragma unroll
        for (int ks = 0; ks < 8; ++ks) { const u32x4 raw = *(const u32x4*)(xq + (row0 + 16 * t) * DM + h * 256 + 32 * ks + 8 * fq); qf[ks] = __builtin_bit_cast(bf16x8, raw); }
        f32x4 st[16];
#pragma unroll
        for (int kt = 0; kt < 16; ++kt) { const LAS unsigned char* kr = (kt < 8 ? B0 : B1) + (16 * (kt & 7) + fr) * 528 + 8 * fq * 2; f32x4 acc = {0.f, 0.f, 0.f, 0.f};
#pragma unroll
            for (int ks = 0; ks < 8; ++ks) acc = MFMA16(lds_frag(kr + ks * 64), qf[ks], acc);
            st[kt] = acc; if (kt & 1) __builtin_amdgcn_sched_barrier(0); }
        float mx = -INFINITY;
#pragma unroll
        for (int kt = 0; kt < 16; ++kt)
#pragma unroll
            for (int v = 0; v < 4; ++v) mx = fmaxf(mx, st[kt][v]);
        mx = fmaxf(mx, __shfl_xor(mx, 16)); mx = fmaxf(mx, __shfl_xor(mx, 32));
        float l = 0.f;
#pragma unroll
        for (int kt = 0; kt < 16; ++kt)
#pragma unroll
            for (int v = 0; v < 4; ++v) { const float e = __builtin_amdgcn_exp2f(st[kt][v] - mx); st[kt][v] = e; l += e; }
        l += __shfl_xor(l, 16); l += __shfl_xor(l, 32);
        rl[t] = __builtin_amdgcn_rcpf(l);
#pragma unroll
        for (int s2 = 0; s2 < 8; ++s2) pk[t][s2] = pack8(st[2 * s2], st[2 * s2 + 1]);
        __builtin_amdgcn_sched_barrier(0);
    }
    __syncthreads();
    { u32x4 v2[8];
#pragma unroll
      for (int i = 0; i < 8; ++i) { const int ch = tid + 512 * (i + 8), dd = ch >> 5, cc = ch & 31; v2[i] = *(const u32x4*)(vt + (size_t)dd * 256 + cc * 8); }
#pragma unroll
      for (int i = 0; i < 8; ++i) { const int ch = tid + 512 * i, dd = ch >> 5, cc = ch & 31; *(LAS u32x4*)(B0 + dd * 528 + cc * 16) = vreg[i]; }
#pragma unroll
      for (int i = 0; i < 8; ++i) { const int ch = tid + 512 * (i + 8), dd = ch >> 5, cc = ch & 31; *(LAS u32x4*)(B1 + (dd & 127) * 528 + cc * 16) = v2[i]; } }
    __syncthreads();
#pragma unroll 1
    for (int hf = 0; hf < 2; ++hf)
#pragma unroll 1
        for (int dg = 0; dg < 2; ++dg) { f32x4 a0[4], a1[4];
#pragma unroll
            for (int i = 0; i < 4; ++i) { a0[i] = (f32x4){0.f, 0.f, 0.f, 0.f}; a1[i] = (f32x4){0.f, 0.f, 0.f, 0.f}; }
#pragma unroll
            for (int s2 = 0; s2 < 8; ++s2)
#pragma unroll
                for (int i = 0; i < 4; ++i) { const LAS unsigned char* vr = (hf ? B1 : B0) + (16 * (4 * dg + i) + fr) * 528 + (32 * s2 + 4 * fq) * 2; const bf16x8 vf = lds_frag2(vr, vr + 32);
                    a0[i] = MFMA16(vf, pk[0][s2], a0[i]); a1[i] = MFMA16(vf, pk[1][s2], a1[i]); }
#pragma unroll
            for (int i = 0; i < 4; ++i) { const f32x4 x0 = a0[i] * rl[0], x1 = a1[i] * rl[1]; u32x2 w0 = {pk2(x0[0], x0[1]), pk2(x0[2], x0[3])}, w1 = {pk2(x1[0], x1[1]), pk2(x1[2], x1[3])};
                bf16_t* dst = xo + row0 * DM + h * 256 + hf * 128 + 16 * (4 * dg + i) + 4 * fq; *(u32x2*)dst = w0; *(u32x2*)(dst + 16 * DM) = w1; } }
    __syncthreads();
}

DI void final_norm(const Params& p) {
    const int lane = threadIdx.x & 63, wave = threadIdx.x >> 6;
    for (int m = blockIdx.x * 8 + wave; m < NTOK; m += gridDim.x * 8) {
        f32x4* xr = (f32x4*)(p.out + (size_t)m * DM) + lane; const f32x4* gr = (const f32x4*)p.norm_final + lane;
        f32x4 v[4]; float s = 0.f;
#pragma unroll
        for (int j = 0; j < 4; ++j) { v[j] = xr[64 * j]; s += (v[j][0] * v[j][0] + v[j][1] * v[j][1]) + (v[j][2] * v[j][2] + v[j][3] * v[j][3]); }
        const float r = __builtin_amdgcn_rsqf(wave_sum(s) * (1.f / DM) + EPS);
#pragma unroll
        for (int j = 0; j < 4; ++j) xr[64 * j] = v[j] * r * gr[64 * j];
    }
}

constexpr int N_PHASES = 12;
#ifndef REP_MASK
#define REP_MASK 0
#endif
#ifndef SKIP_MASK
#define SKIP_MASK 0
#endif
#ifndef TS_PROBE
#define TS_PROBE 0
#define TS_A 0
#define TS_B 0
#endif
constexpr size_t WS_TS = 2 * MiB + 768 * 1024;
template <int PASS> DI void run_program(const Params& p, LAS unsigned char* L, cg::grid_group& grid) {
    unsigned char* ws = p.ws;
    const int lo = p.ph_lo, hi = p.ph_hi, G = gridDim.x, bid = blockIdx.x;
#define IN(k) (lo <= (k) && (k) < hi && !(PASS == 0 && ((SKIP_MASK >> (k)) & 1)))
#define SEAM(k) do { if (lo <= (k) && (k) + 1 < hi) grid.sync(); if (TS_PROBE && PASS == 1 && bid == 0 && threadIdx.x == 0) ((unsigned long long*)(ws + WS_TS))[(k) + 1] = __builtin_amdgcn_s_memrealtime(); } while (0)
    bf16_t* const xb = (bf16_t*)(ws + WS_XB); bf16_t* const proj = (bf16_t*)(ws + WS_PROJ); bf16_t* const mix = (bf16_t*)(ws + WS_MIX); bf16_t* const xq = (bf16_t*)(ws + WS_XQ);
    float* const part1 = (float*)(ws + WS_PART1); float* const part2 = (float*)(ws + WS_PART2);

    if (TS_PROBE && PASS == 1 && bid == 0 && threadIdx.x == 0) ((unsigned long long*)(ws + WS_TS))[0] = __builtin_amdgcn_s_memrealtime();
    if (IN(0)) { p0_prologue(p, L); } SEAM(0);
    if (IN(1)) { pg8::Gemm g{xb, (const bf16_t*)(ws + WS_WIN), NTOK + NMEM, INC + 2048, DM}; OrderP1 S{G, bid}; EpiProj E{proj, (bf16_t*)(ws + WS_XKV)};
        pg8::gemm_phase<EpiProj, OrderP1, true, true>(L, g, S, E); } SEAM(1);
    if (IN(2)) { for (int rep = 0; rep < 1 + ((REP_MASK >> 2) & 1); ++rep) for (int u = bid; u < 1024; u += G) hgrn_a_unit(p, L, u); } SEAM(2);
    if (IN(3)) { hgrn_scan(p); for (int rep = 0; rep < 1 + ((REP_MASK >> 3) & 1); ++rep) for (int u = bid; u < 256; u += G) swa_unit(p, L, u); } SEAM(3);
    if (IN(4)) { for (int rep = 0; rep < 1 + ((REP_MASK >> 4) & 1); ++rep) for (int u = bid; u < 1024; u += G) hgrn_c_unit(p, L, u); } SEAM(4);
    if (IN(5)) { pg8::Gemm g{mix, (const bf16_t*)(ws + WS_WOUT), NTOK, DM, DM}; pg8::StaticOrder S; S.init(NTOK, DM, G, bid); EpiRes<0> E{p.x, xb, part1};
        pg8::gemm_phase<EpiRes<0>, pg8::StaticOrder, true, true>(L, g, S, E); } SEAM(5);
    if (IN(6)) { pg8::Gemm g{xb, (const bf16_t*)(ws + WS_WXQ), NTOK, DM, DM}; pg8::StaticOrder S; S.init(NTOK, DM, G, bid); EpiScale E{xq, part1, 0.0625f * LOG2E};
        pg8::gemm_phase<EpiScale, pg8::StaticOrder, true, true>(L, g, S, E); } SEAM(6);
    if (IN(7)) { for (int rep = 0; rep < 1 + ((REP_MASK >> 7) & 1); ++rep) for (int u = bid; u < 256; u += G) xattn_unit(p, L, u); } SEAM(7);
    if (IN(8)) { pg8::Gemm g{mix, (const bf16_t*)(ws + WS_WXO), NTOK, DM, DM}; pg8::StaticOrder S; S.init(NTOK, DM, G, bid); EpiRes<1> E{xb, xb, part2};
        pg8::gemm_phase<EpiRes<1>, pg8::StaticOrder, true, true>(L, g, S, E); } SEAM(8);
    if (IN(9)) { pg8::Gemm g{xb, (const bf16_t*)(ws + WS_WGU), NTOK, 2 * FFH, DM}; pg8::StaticOrder S; S.init(NTOK, 2 * FFH, G, bid); EpiSwiGLU E{proj, part2};
        pg8::gemm_phase<EpiSwiGLU, pg8::StaticOrder, true, true>(L, g, S, E); } SEAM(9);
    if (IN(10)) { pg8::Gemm g{proj, (const bf16_t*)(ws + WS_WDN), NTOK, DM, FFH}; pg8::StaticOrder S; S.init(NTOK, DM, G, bid); EpiRes<2> E{xb, p.out, nullptr};
        pg8::gemm_phase<EpiRes<2>, pg8::StaticOrder, true, true>(L, g, S, E); } SEAM(10);
    if (IN(11)) { final_norm(p); } SEAM(11);
#undef IN
#undef SEAM
}
__global__ void __launch_bounds__(512, 2) fwd_kernel(Params p) {
    extern __shared__ __attribute__((aligned(16))) unsigned char lds_raw[];
    LAS unsigned char* L = (LAS unsigned char*)lds_raw;
    cg::grid_group grid = cg::this_grid();
#if SKIP_MASK
    run_program<0>(p, L, grid); grid.sync();
#endif
    run_program<1>(p, L, grid);
#if TS_PROBE
    grid.sync();
    if (threadIdx.x == 0) { const unsigned long long* ts = (const unsigned long long*)(p.ws + WS_TS); const unsigned long long dt = 9ull * (__hip_atomic_load(ts + TS_A + 1, __ATOMIC_RELAXED, __HIP_MEMORY_SCOPE_AGENT) - __hip_atomic_load(ts + TS_A, __ATOMIC_RELAXED, __HIP_MEMORY_SCOPE_AGENT));
        const unsigned long long t0 = __builtin_amdgcn_s_memrealtime(); if (dt < 200000ull) while (__builtin_amdgcn_s_memrealtime() - t0 < dt) __builtin_amdgcn_s_sleep(8); }
    __syncthreads();
#endif
}

extern "C" void kernel_launch(void* const* d_in, const int* in_sizes, int n_in, void* d_out, int out_size, void* d_ws, size_t ws_size, hipStream_t stream) {
    static int grid = 0;
    if (grid == 0) {
        int dev = 0, cus = 0, per_cu = 0;
        if (hipGetDevice(&dev) != hipSuccess || hipDeviceGetAttribute(&cus, hipDeviceAttributeMultiprocessorCount, dev) != hipSuccess) { fprintf(stderr, "kernel_launch: device query failed\n"); grid = -1; return; }
        if (hipFuncSetAttribute((const void*)fwd_kernel, hipFuncAttributeMaxDynamicSharedMemorySize, LDS_BYTES) != hipSuccess) { fprintf(stderr, "kernel_launch: hipFuncSetAttribute failed\n"); grid = -1; return; }
        if (hipOccupancyMaxActiveBlocksPerMultiprocessor(&per_cu, (const void*)fwd_kernel, 512, LDS_BYTES) != hipSuccess || per_cu < 1) { fprintf(stderr, "kernel_launch: occupancy query gave %d\n", per_cu); per_cu = 1; }
        (void)hipGetLastError();
        grid = cus * 1;
        if (ws_size < 236 * MiB) { fprintf(stderr, "kernel_launch: workspace too small (%zu)\n", ws_size); grid = -1; return; }
    }
    if (grid < 0) return;
    Params p{};
    p.x = (const float*)d_in[0]; p.mem = (const float*)d_in[1]; p.pos = (const int*)d_in[2]; p.norm_mix = (const float*)d_in[3]; p.w_in = (const float*)d_in[4];
    p.sinks = (const float*)d_in[5]; p.att_gain = (const float*)d_in[6]; p.lb_logits = (const float*)d_in[7]; p.hg_gain = (const float*)d_in[8]; p.w_out = (const float*)d_in[9];
    p.norm_xattn = (const float*)d_in[10]; p.norm_mem = (const float*)d_in[11]; p.w_xq = (const float*)d_in[12]; p.w_xkv = (const float*)d_in[13]; p.w_xo = (const float*)d_in[14];
    p.norm_ffn = (const float*)d_in[15]; p.w_gu = (const float*)d_in[16]; p.w_down = (const float*)d_in[17]; p.norm_final = (const float*)d_in[18];
    p.out = (float*)d_out; p.ws = (unsigned char*)d_ws;
#if ONE_LAUNCH
    p.ph_lo = 0; p.ph_hi = N_PHASES;
    void* args[] = {&p};
    hipError_t e = hipLaunchCooperativeKernel((const void*)fwd_kernel, dim3(grid), dim3(512), args, LDS_BYTES, stream);
    if (e != hipSuccess) fprintf(stderr, "kernel_launch: cooperative launch failed: %s (grid %d)\n", hipGetErrorString(e), grid);
#else
    for (int k = 0; k < N_PHASES; ++k) { p.ph_lo = k; p.ph_hi = k + 1; hipLaunchKernelGGL(fwd_kernel, dim3(grid), dim3(512), LDS_BYTES, stream, p); }
#endif
}
```

```cpp
#include <hip/hip_runtime.h>
#include <hip/hip_cooperative_groups.h>
#include <cstdio>
#include <cstdint>
namespace cg = cooperative_groups;
#ifndef ONE_LAUNCH
#define ONE_LAUNCH 1
#endif
namespace pg8 {
#define PG8_LAS __attribute__((address_space(3)))
typedef unsigned short bf16_t;
typedef short bf16x8 __attribute__((ext_vector_type(8)));
typedef float f32x4 __attribute__((ext_vector_type(4)));
typedef unsigned u32x4 __attribute__((ext_vector_type(4)));
constexpr int BM = 256, BK = 64, HALF = 128, HTB = HALF * BK * 2  , STAGE_BYTES = 8 * HTB, NXCD = 8, WGM = 8;

__host__ __device__ __forceinline__ int lds_byte(int r, int c) { const int st = (r >> 4) * 2 + (c >> 5), rr = r & 15, cc = c & 31, ob = rr * 64 + cc * 2; return st * 1024 + (ob ^ (((ob >> 9) & 1) << 5)); }
__host__ __device__ __forceinline__ void stage_rc(int b, int& R, int& C) { const int st = b / 1024, sb = b % 1024, swz = sb ^ (((sb >> 9) & 1) << 5); R = (st >> 1) * 16 + swz / 64; C = (st & 1) * 32 + (swz % 64) / 2; }
__host__ __device__ __forceinline__ int perm32(int rho) { const int n = rho >> 4, i = rho & 15; return 8 * (i >> 2) + 4 * n + (i & 3); }

struct Unit { int pm, pn; };
struct Gemm { const bf16_t* A; const bf16_t* Bt; int M, N, K; };

struct StaticOrder {
    int nM, nN, nwg, G, c;
    __host__ __device__ void init(int M, int N, int G_, int c_) { nM = M / BM; nN = N / BM; nwg = nM * nN; G = G_; c = c_; }
    __host__ __device__ bool next(int i, Unit& u) const {
        const long L = (long)i * G + c; if (L >= nwg) return false;
        int wgid = (int)L; { const int q = nwg / NXCD, r = nwg % NXCD, xcd = wgid % NXCD, off = wgid / NXCD; wgid = (xcd < r ? xcd * (q + 1) : r * (q + 1) + (xcd - r) * q) + off; }
        const int nig = WGM * nN, gid = wgid / nig, fm = gid * WGM, gsz = (nM - fm) < WGM ? (nM - fm) : WGM;
        u.pm = fm + ((wgid % nig) % gsz); u.pn = (wgid % nig) / gsz; return true;
    }
    __device__ __forceinline__ void a_ready(const Unit&) const {}
    __device__ __forceinline__ void done(const Unit&) const {}
};

__device__ __forceinline__ unsigned cvt_pk_bf16(float lo, float hi) { unsigned r; asm volatile("v_cvt_pk_bf16_f32 %0, %1, %2" : "=v"(r) : "v"(lo), "v"(hi)); return r; }
template <class Epi, class Sched, bool ALIGN_EPI = false, bool SP2 = false>
__device__ __forceinline__ void gemm_phase(PG8_LAS unsigned char* lds, const Gemm g, const Sched& S, const Epi& E) {
    const int tid = threadIdx.x, wid = __builtin_amdgcn_readfirstlane(tid >> 6), lane = tid & 63, wr = wid >> 2, wc = wid & 3, fr = lane & 15, fq = lane >> 4;
    const int K = g.K, nt = K / BK;
    unsigned voffA[2], voffB[2];
#pragma unroll
    for (int i = 0; i < 2; ++i) { int R, C; stage_rc(tid * 16 + i * 8192, R, C); const int Rb = Epi::PERM ? ((R & ~31) + perm32(R & 31)) : R;
        voffA[i] = (unsigned)(R * K + C) * 2u; voffB[i] = (unsigned)(Rb * K + C) * 2u; }
    const size_t kstep = (size_t)(BK * 2);
    const size_t hstep = (size_t)HALF * K * 2;
    const size_t tstep = 2 * hstep;
    const unsigned ldsw = (unsigned)wid * 1024u;
    const int aoff = lds_byte(wr * 64 + fr, fq * 8), boff = lds_byte(wc * 32 + fr, fq * 8);
#define PG8_SA(b, h) (((b) * 2 + (h)) * HTB)
#define PG8_SB(b, h) ((4 + (b) * 2 + (h)) * HTB)
#define PG8_STAGE(bufoff, gbase, voff) do { _Pragma("unroll") for (int _i = 0; _i < 2; ++_i) \
        __builtin_amdgcn_global_load_lds((const unsigned*)((const char*)(gbase) + (voff)[_i]), (PG8_LAS unsigned*)(lds + (bufoff) + ldsw + _i * 8192), 16, 0, 0); } while (0)
#define PG8_LDA(dst, b, h) do { _Pragma("unroll") for (int m = 0; m < 4; ++m) _Pragma("unroll") for (int k = 0; k < 2; ++k) dst[m][k] = *(const PG8_LAS bf16x8*)(lds + PG8_SA(b, h) + aoff + m * 2048 + k * 1024); } while (0)
#define PG8_LDB(dst, b, h) do { _Pragma("unroll") for (int n = 0; n < 2; ++n) _Pragma("unroll") for (int k = 0; k < 2; ++k) dst[n][k] = *(const PG8_LAS bf16x8*)(lds + PG8_SB(b, h) + boff + n * 2048 + k * 1024); } while (0)
#define PG8_MMA(ai, bj, At, Bt) do { __builtin_amdgcn_s_setprio(1); _Pragma("unroll") for (int m = 0; m < 4; ++m) _Pragma("unroll") for (int n = 0; n < 2; ++n) _Pragma("unroll") for (int k = 0; k < 2; ++k) \
        acc[ai][bj][m][n] = __builtin_amdgcn_mfma_f32_16x16x32_bf16(Bt[n][k], At[m][k], acc[ai][bj][m][n], 0, 0, 0); __builtin_amdgcn_s_setprio(0); } while (0)
#define PG8_WAIT_V(n) asm volatile("s_waitcnt vmcnt(" #n ")" ::: "memory")
#define PG8_WAIT_L(n) asm volatile("s_waitcnt lgkmcnt(" #n ")" ::: "memory")
#define PG8_BAR __builtin_amdgcn_s_barrier()
#define PG8_SCHED __builtin_amdgcn_sched_barrier(0)
    Unit cur, nxt; int ui = 0;
    if (!S.next(0, cur)) return;
    f32x4 acc[2][2][4][2];
#pragma unroll
    for (int a = 0; a < 2; ++a)
#pragma unroll
        for (int b = 0; b < 2; ++b)
#pragma unroll
            for (int m = 0; m < 4; ++m)
#pragma unroll
                for (int n = 0; n < 2; ++n) acc[a][b][m][n] = (f32x4){0.f, 0.f, 0.f, 0.f};
    bf16x8 At[4][2], B0[2][2], B1[2][2];
    const char* cA = (const char*)g.A + (size_t)cur.pm * tstep; const char* cB = (const char*)g.Bt + (size_t)cur.pn * tstep;
    S.a_ready(cur);
    if constexpr (SP2) {
        PG8_STAGE(PG8_SB(0, 0), cB, voffB); PG8_STAGE(PG8_SB(0, 1), cB + hstep, voffB); PG8_STAGE(PG8_SA(0, 0), cA, voffA); PG8_STAGE(PG8_SA(0, 1), cA + hstep, voffA);
        if (wr == 1) PG8_BAR;
        PG8_WAIT_V(2); PG8_BAR;
        PG8_STAGE(PG8_SB(1, 0), cB + kstep, voffB); PG8_STAGE(PG8_SA(1, 0), cA + kstep, voffA); PG8_STAGE(PG8_SB(1, 1), cB + hstep + kstep, voffB);
        PG8_WAIT_V(6); PG8_BAR;
    } else {
        PG8_STAGE(PG8_SB(0, 0), cB, voffB); PG8_STAGE(PG8_SA(0, 0), cA, voffA); PG8_STAGE(PG8_SB(0, 1), cB + hstep, voffB); PG8_STAGE(PG8_SA(0, 1), cA + hstep, voffA);
        if (wr == 1) PG8_BAR;
        PG8_WAIT_V(4); PG8_BAR;
        PG8_STAGE(PG8_SB(1, 0), cB + kstep, voffB); PG8_STAGE(PG8_SA(1, 0), cA + kstep, voffA); PG8_STAGE(PG8_SB(1, 1), cB + hstep + kstep, voffB);
        PG8_WAIT_V(6); PG8_BAR;
    }
    for (;;) {
        const bool has_next = S.next(ui + 1, nxt);
        const char* nA = has_next ? (const char*)g.A + (size_t)nxt.pm * tstep : cA; const char* nB = has_next ? (const char*)g.Bt + (size_t)nxt.pn * tstep : cB;
        for (int t = 0; t < nt; t += 2) {
            const bool last = (t == nt - 2);
            const char* a1 = cA + (size_t)(t + 1) * kstep;
            const char* a2 = last ? nA : cA + (size_t)(t + 2) * kstep; const char* b2 = last ? nB : cB + (size_t)(t + 2) * kstep;
            const char* a3 = a2 + kstep; const char* b3 = b2 + kstep;
            if (last && has_next) S.a_ready(nxt);
            if constexpr (SP2) {
            PG8_LDB(B0, 0, 0); PG8_LDB(B1, 0, 1); PG8_SCHED; PG8_LDA(At, 0, 0); PG8_STAGE(PG8_SA(1, 1), a1 + hstep, voffA);
            PG8_WAIT_V(8); PG8_WAIT_L(0); PG8_BAR; PG8_MMA(0, 0, At, B0); PG8_MMA(0, 1, At, B1); PG8_BAR; PG8_SCHED;
            PG8_LDA(At, 0, 1); PG8_STAGE(PG8_SB(0, 0), b2, voffB); PG8_STAGE(PG8_SB(0, 1), b2 + hstep, voffB); PG8_STAGE(PG8_SA(0, 0), a2, voffA);
            PG8_WAIT_V(8); PG8_WAIT_L(0); PG8_BAR; PG8_MMA(1, 0, At, B0); PG8_MMA(1, 1, At, B1); PG8_BAR; PG8_SCHED;
            PG8_LDB(B0, 1, 0); PG8_LDB(B1, 1, 1); PG8_SCHED; PG8_LDA(At, 1, 0); PG8_STAGE(PG8_SA(0, 1), a2 + hstep, voffA);
            PG8_WAIT_V(8); PG8_WAIT_L(0); PG8_BAR; PG8_MMA(0, 0, At, B0); PG8_MMA(0, 1, At, B1); PG8_BAR; PG8_SCHED;
            PG8_LDA(At, 1, 1); PG8_STAGE(PG8_SB(1, 0), b3, voffB); PG8_STAGE(PG8_SB(1, 1), b3 + hstep, voffB); PG8_STAGE(PG8_SA(1, 0), a3, voffA);
            PG8_WAIT_V(8); PG8_WAIT_L(0); PG8_BAR; PG8_MMA(1, 0, At, B0); PG8_MMA(1, 1, At, B1); PG8_BAR; PG8_SCHED;
            } else {
            PG8_LDB(B0, 0, 0); PG8_SCHED; PG8_LDA(At, 0, 0); PG8_STAGE(PG8_SA(1, 1), a1 + hstep, voffA);
            PG8_WAIT_L(8); PG8_BAR; PG8_WAIT_L(0); PG8_MMA(0, 0, At, B0); PG8_BAR; PG8_SCHED;
            PG8_LDB(B1, 0, 1); PG8_STAGE(PG8_SB(0, 0), b2, voffB);
            PG8_BAR; PG8_WAIT_L(0); PG8_MMA(0, 1, At, B1); PG8_BAR;
            PG8_LDA(At, 0, 1); PG8_STAGE(PG8_SA(0, 0), a2, voffA);
            PG8_BAR; PG8_WAIT_L(0); PG8_MMA(1, 0, At, B0); PG8_BAR; PG8_SCHED;
            PG8_STAGE(PG8_SB(0, 1), b2 + hstep, voffB);
            PG8_WAIT_V(6); PG8_BAR; PG8_MMA(1, 1, At, B1); PG8_BAR;
            PG8_LDB(B0, 1, 0); PG8_SCHED; PG8_LDA(At, 1, 0); PG8_STAGE(PG8_SA(0, 1), a2 + hstep, voffA);
            PG8_WAIT_L(8); PG8_BAR; PG8_WAIT_L(0); PG8_MMA(0, 0, At, B0); PG8_BAR; PG8_SCHED;
            PG8_LDB(B1, 1, 1); PG8_STAGE(PG8_SB(1, 0), b3, voffB);
            PG8_BAR; PG8_WAIT_L(0); PG8_MMA(0, 1, At, B1); PG8_BAR;
            PG8_LDA(At, 1, 1); PG8_STAGE(PG8_SA(1, 0), a3, voffA);
            PG8_BAR; PG8_WAIT_L(0); PG8_MMA(1, 0, At, B0); PG8_BAR; PG8_SCHED;
            PG8_STAGE(PG8_SB(1, 1), b3 + hstep, voffB);
            PG8_WAIT_V(6); PG8_BAR; PG8_MMA(1, 1, At, B1); PG8_BAR;
            }
        }
        if constexpr (ALIGN_EPI) { if (wr == 0) PG8_BAR; }
        if constexpr (!Epi::AFTER_DRAIN) { E(acc, cur, wr, wc, fr, fq); S.done(cur); }
        if (!has_next) break;
#pragma unroll
        for (int a = 0; a < 2; ++a)
#pragma unroll
            for (int b = 0; b < 2; ++b)
#pragma unroll
                for (int m = 0; m < 4; ++m)
#pragma unroll
                    for (int n = 0; n < 2; ++n) acc[a][b][m][n] = (f32x4){0.f, 0.f, 0.f, 0.f};
        cur = nxt; cA = nA; cB = nB; ++ui;
        if constexpr (ALIGN_EPI) { if (wr == 1) PG8_BAR; }
    }
    PG8_WAIT_V(0);
    if constexpr (!ALIGN_EPI) { if (wr == 0) PG8_BAR; }
    PG8_BAR;
    if constexpr (Epi::AFTER_DRAIN) { E.fused(acc, cur, wr, wc, fr, fq, lds, wid, lane); S.done(cur); }
#undef PG8_SA
#undef PG8_SB
#undef PG8_STAGE
#undef PG8_LDA
#undef PG8_LDB
#undef PG8_MMA
#undef PG8_WAIT_V
#undef PG8_WAIT_L
#undef PG8_BAR
#undef PG8_SCHED
}
}

#define DI __device__ __forceinline__
#define LAS __attribute__((address_space(3)))
using pg8::bf16_t; using pg8::bf16x8; using pg8::f32x4; using pg8::u32x4; using pg8::Unit;
typedef unsigned u32x2 __attribute__((ext_vector_type(2)));
typedef float f32x2 __attribute__((ext_vector_type(2)));
typedef __bf16 bf16x2_t __attribute__((ext_vector_type(2)));
constexpr int NTOK = 16384, DM = 1024, SEQ = 2048, NMEM = 2048  , INC = 2816, FFH = 2816;
constexpr float EPS = 1e-6f, LOG2E = 1.4426950408889634f;
constexpr size_t MiB = 1u << 20;
constexpr size_t WS_PART1 = 0, WS_PART2 = 1 * MiB, WS_DECAY = 2 * MiB;
constexpr size_t WS_WIN = 3 * MiB;
constexpr size_t WS_WOUT = WS_WIN + 19 * 256 * 1024 * 2;
constexpr size_t WS_WXQ = WS_WOUT + 2 * MiB, WS_WXO = WS_WXQ + 2 * MiB, WS_WGU = WS_WXO + 2 * MiB, WS_WDN = WS_WGU + 11 * MiB;
constexpr size_t WS_XB = 36 * MiB;
constexpr size_t WS_PROJ = 72 * MiB;
constexpr size_t WS_XKV = 160 * MiB;
constexpr size_t WS_MIX = 168 * MiB;
constexpr size_t WS_XVT = 232 * MiB;
constexpr size_t WS_XQ = 200 * MiB;
constexpr int LDS_BYTES = 147456;

struct Params {
    const float *x, *mem; const int* pos;
    const float *norm_mix, *w_in, *sinks, *att_gain, *lb_logits, *hg_gain, *w_out, *norm_xattn, *norm_mem, *w_xq, *w_xkv, *w_xo, *norm_ffn, *w_gu, *w_down, *norm_final;
    float* out; unsigned char* ws; int ph_lo, ph_hi;
};

DI float bf2f(unsigned v) { return __uint_as_float(v << 16); }
DI unsigned pk2(float lo, float hi) { f32x2 v = {lo, hi}; bf16x2_t b = __builtin_convertvector(v, bf16x2_t); return __builtin_bit_cast(unsigned, b); }
DI float lo_f(unsigned w) { return __uint_as_float(w << 16); }
DI float hi_f(unsigned w) { return __uint_as_float(w & 0xffff0000u); }
DI float sigmoidf_(float z) { return __builtin_amdgcn_rcpf(1.f + __expf(-z)); }
DI float wave_sum(float v) {
#pragma unroll
    for (int o = 1; o < 64; o <<= 1) v += __shfl_xor(v, o);
    return v;
}
#define MFMA16(a, b, c) __builtin_amdgcn_mfma_f32_16x16x32_bf16((a), (b), (c), 0, 0, 0)
DI bf16x8 lds_frag(const LAS unsigned char* p) { return *(const LAS bf16x8*)p; }
DI bf16x8 lds_frag2(const LAS unsigned char* p0, const LAS unsigned char* p1) { const u32x2 a = *(const LAS u32x2*)p0, b = *(const LAS u32x2*)p1; u32x4 w = {a.x, a.y, b.x, b.y}; return __builtin_bit_cast(bf16x8, w); }
DI bf16x8 lds_frag_lo(const LAS unsigned char* p0) { const u32x2 a = *(const LAS u32x2*)p0; u32x4 w = {a.x, a.y, 0u, 0u}; return __builtin_bit_cast(bf16x8, w); }
DI bf16x8 pack8(f32x4 a, f32x4 b) { u32x4 w = {pk2(a[0], a[1]), pk2(a[2], a[3]), pk2(b[0], b[1]), pk2(b[2], b[3])}; return __builtin_bit_cast(bf16x8, w); }

struct EpiProj {
    static constexpr bool PERM = true, AFTER_DRAIN = false;
    bf16_t* proj; bf16_t* xkv;
    DI void store_rows(const f32x4 (&acc)[2][2][4][2], bf16_t* p0, size_t ldc) const {
#pragma unroll
        for (int ai = 0; ai < 2; ++ai)
#pragma unroll
            for (int m = 0; m < 4; ++m) { bf16_t* rowp = p0 + (size_t)(ai * 128 + m * 16) * ldc;
#pragma unroll
                for (int bj = 0; bj < 2; ++bj) { const f32x4 v0 = acc[ai][bj][m][0], v1 = acc[ai][bj][m][1];
                    u32x4 w = {pk2(v0[0], v0[1]), pk2(v0[2], v0[3]), pk2(v1[0], v1[1]), pk2(v1[2], v1[3])}; *(u32x4*)(rowp + bj * 128) = w; } }
    }
    DI void operator()(const f32x4 (&acc)[2][2][4][2], const Unit& u, int wr, int wc, int fr, int fq) const {
        const int rl = wr * 64 + fr, cl = wc * 32 + 8 * fq;
        if (u.pm < 64) store_rows(acc, proj + (size_t)(u.pm * 256 + rl) * INC + u.pn * 256 + cl, INC);
        else if (u.pn < 15) store_rows(acc, xkv + (size_t)((u.pm - 64) * 256 + rl) * 2048 + (u.pn - 11) * 256 + cl, 2048);
        else {
            bf16_t* vt = xkv + (WS_XVT - WS_XKV) / 2 + (size_t)((u.pm - 64) * 4 + (u.pn - 15)) * 65536 + (size_t)cl * 256 + rl;
#pragma unroll
            for (int ai = 0; ai < 2; ++ai)
#pragma unroll
                for (int m = 0; m < 4; ++m)
#pragma unroll
                    for (int bj = 0; bj < 2; ++bj)
#pragma unroll
                        for (int n = 0; n < 2; ++n) { const f32x4 v = acc[ai][bj][m][n]; bf16_t* q = vt + (size_t)(bj * 128 + 4 * n) * 256 + ai * 128 + m * 16;
                            const unsigned w0 = pk2(v[0], v[1]), w1 = pk2(v[2], v[3]);
                            q[0] = (bf16_t)w0; q[256] = (bf16_t)(w0 >> 16); q[512] = (bf16_t)w1; q[768] = (bf16_t)(w1 >> 16); }
        }
    }
};
template <int MODE> struct EpiRes {
    static constexpr bool PERM = true, AFTER_DRAIN = false;
    const void* base; void* out; float* part;
    DI void operator()(const f32x4 (&acc)[2][2][4][2], const Unit& u, int wr, int wc, int fr, int fq) const {
        const int col0 = u.pn * 256 + wc * 32 + 8 * fq;
#pragma unroll
        for (int ai = 0; ai < 2; ++ai)
#pragma unroll
            for (int m = 0; m < 4; ++m) { const int row = u.pm * 256 + ai * 128 + wr * 64 + m * 16 + fr; const size_t off = (size_t)row * DM + col0; float ss = 0.f;
#pragma unroll
                for (int bj = 0; bj < 2; ++bj) { f32x4 v0, v1;
                    if (MODE == 0) { const float* bp = (const float*)base + off + bj * 128; v0 = *(const f32x4*)bp; v1 = *(const f32x4*)(bp + 4); }
                    else { const u32x4 r = *(const u32x4*)((const bf16_t*)base + off + bj * 128); v0 = (f32x4){lo_f(r[0]), hi_f(r[0]), lo_f(r[1]), hi_f(r[1])}; v1 = (f32x4){lo_f(r[2]), hi_f(r[2]), lo_f(r[3]), hi_f(r[3])}; }
                    v0 = v0 + acc[ai][bj][m][0]; v1 = v1 + acc[ai][bj][m][1];
                    if (MODE == 2) { float* op = (float*)out + off + bj * 128; *(f32x4*)op = v0; *(f32x4*)(op + 4) = v1; }
                    else { u32x4 w = {pk2(v0[0], v0[1]), pk2(v0[2], v0[3]), pk2(v1[0], v1[1]), pk2(v1[2], v1[3])}; *(u32x4*)((bf16_t*)out + off + bj * 128) = w;
                        const float a0 = lo_f(w[0]), a1 = hi_f(w[0]), a2 = lo_f(w[1]), a3 = hi_f(w[1]), a4 = lo_f(w[2]), a5 = hi_f(w[2]), a6 = lo_f(w[3]), a7 = hi_f(w[3]);
                        ss += ((a0 * a0 + a1 * a1) + (a2 * a2 + a3 * a3)) + ((a4 * a4 + a5 * a5) + (a6 * a6 + a7 * a7)); } }
                if (MODE != 2) { ss += __shfl_xor(ss, 16); ss += __shfl_xor(ss, 32); if (fq == 0) part[(size_t)row * 16 + u.pn * 4 + wc] = ss; } }
    }
};
DI float row_rstd(const float* part, int row) {
    const f32x4* p = (const f32x4*)(part + (size_t)row * 16); const f32x4 a = p[0], b = p[1], c = p[2], d = p[3];
    const float s = ((a[0] + a[1]) + (a[2] + a[3])) + ((b[0] + b[1]) + (b[2] + b[3])) + ((c[0] + c[1]) + (c[2] + c[3])) + ((d[0] + d[1]) + (d[2] + d[3]));
    return __builtin_amdgcn_rsqf(s * (1.0f / DM) + EPS);
}
struct EpiScale {
    static constexpr bool PERM = true, AFTER_DRAIN = false;
    bf16_t* O; const float* part; float cs;
    DI void operator()(const f32x4 (&acc)[2][2][4][2], const Unit& u, int wr, int wc, int fr, int fq) const {
        const int row0 = u.pm * 256 + wr * 64 + fr, col0 = u.pn * 256 + wc * 32 + 8 * fq;
#pragma unroll
        for (int ai = 0; ai < 2; ++ai)
#pragma unroll
            for (int m = 0; m < 4; ++m) { const int row = row0 + ai * 128 + m * 16; const float s = row_rstd(part, row) * cs; bf16_t* rowp = O + (size_t)row * DM + col0;
#pragma unroll
                for (int bj = 0; bj < 2; ++bj) { const f32x4 v0 = acc[ai][bj][m][0] * s, v1 = acc[ai][bj][m][1] * s;
                    u32x4 w = {pk2(v0[0], v0[1]), pk2(v0[2], v0[3]), pk2(v1[0], v1[1]), pk2(v1[2], v1[3])}; *(u32x4*)(rowp + bj * 128) = w; } }
    }
};
struct EpiSwiGLU {
    static constexpr bool PERM = true, AFTER_DRAIN = false;
    bf16_t* H; const float* part;
    DI void operator()(const f32x4 (&acc)[2][2][4][2], const Unit& u, int wr, int wc, int fr, int fq) const {
        const int row0 = u.pm * 256 + wr * 64 + fr, col0 = u.pn * 128 + wc * 32 + 8 * fq;
#pragma unroll
        for (int ai = 0; ai < 2; ++ai)
#pragma unroll
            for (int m = 0; m < 4; ++m) { const int row = row0 + ai * 128 + m * 16; const float s = row_rstd(part, row); unsigned w[4];
#pragma unroll
                for (int n = 0; n < 2; ++n) { const f32x4 g = acc[ai][0][m][n] * s, up = acc[ai][1][m][n] * s; float h[4];
#pragma unroll
                    for (int e = 0; e < 4; ++e) h[e] = g[e] * sigmoidf_(g[e]) * up[e];
                    w[2 * n] = pk2(h[0], h[1]); w[2 * n + 1] = pk2(h[2], h[3]); }
                u32x4 ww = {w[0], w[1], w[2], w[3]}; *(u32x4*)(H + (size_t)row * FFH + col0) = ww; }
    }
};
struct OrderP1 {
    int G, c;
    DI bool next(int i, Unit& u) const { const long L = (long)i * G + c; if (L >= 768) return false; const int x = (int)(L & 7), j = (int)(L >> 3);
        if (j < 88) { u.pm = 8 * x + (j & 7); u.pn = j >> 3; } else { u.pm = 64 + x; u.pn = 11 + (j - 88); } return true; }
    DI void a_ready(const Unit&) const {}
    DI void done(const Unit&) const {}
};

template <int MAP> DI int wmap(int c) { if (MAP == 0) return c; return c < FFH ? ((c >> 7) * 256 + (c & 127)) : (((c - FFH) >> 7) * 256 + 128 + ((c - FFH) & 127)); }
template <int MAP> DI void p0_transpose_item(const float* W, int K, int N, const float* gain, bf16_t* WT, LAS float* scr, int item, int lane) {
    const int nblk = N / 32, kb = item / nblk, nb = item % nblk, k0 = 64 * kb, n0 = 32 * nb;
    float v[32];
    const float* wp = W + (size_t)(k0 + (lane >> 5)) * N + n0 + (lane & 31);
#pragma unroll
    for (int i = 0; i < 32; ++i) v[i] = wp[(size_t)(2 * i) * N];
    if (gain) {
#pragma unroll
        for (int i = 0; i < 32; ++i) v[i] *= gain[k0 + 2 * i + (lane >> 5)];
    }
#pragma unroll
    for (int i = 0; i < 32; ++i) scr[(2 * i + (lane >> 5)) * 33 + (lane & 31)] = v[i];
    asm volatile("s_waitcnt lgkmcnt(0)" ::: "memory");
    const int c = lane & 7;
#pragma unroll
    for (int j = 0; j < 4; ++j) { const int n = (lane >> 3) + 8 * j; const LAS float* s = scr + (8 * c) * 33 + n;
        u32x4 o = {pk2(s[0 * 33], s[1 * 33]), pk2(s[2 * 33], s[3 * 33]), pk2(s[4 * 33], s[5 * 33]), pk2(s[6 * 33], s[7 * 33])};
        *(u32x4*)(WT + (size_t)wmap<MAP>(n0 + n) * K + k0 + 8 * c) = o; }
    asm volatile("s_waitcnt lgkmcnt(0)" ::: "memory");
}
DI void rms_rows2_to_bf16(const float* x0, const float* x1, const float* gain, bf16_t* o0, bf16_t* o1, int lane) {
    const f32x4* xa = (const f32x4*)x0 + lane; const f32x4* xc = (const f32x4*)x1 + lane; const f32x4* gr = (const f32x4*)gain + lane;
    f32x4 v[4], w[4]; float s = 0.f, t = 0.f;
#pragma unroll
    for (int j = 0; j < 4; ++j) { v[j] = xa[64 * j]; w[j] = xc[64 * j]; }
#pragma unroll
    for (int j = 0; j < 4; ++j) { s += (v[j][0] * v[j][0] + v[j][1] * v[j][1]) + (v[j][2] * v[j][2] + v[j][3] * v[j][3]); t += (w[j][0] * w[j][0] + w[j][1] * w[j][1]) + (w[j][2] * w[j][2] + w[j][3] * w[j][3]); }
    const float r = __builtin_amdgcn_rsqf(wave_sum(s) * (1.f / DM) + EPS), q = __builtin_amdgcn_rsqf(wave_sum(t) * (1.f / DM) + EPS);
    u32x2* p8 = (u32x2*)o0 + lane; u32x2* q8 = (u32x2*)o1 + lane;
#pragma unroll
    for (int j = 0; j < 4; ++j) { const f32x4 g = gr[64 * j];
        u32x2 a = {pk2(v[j][0] * r * g[0], v[j][1] * r * g[1]), pk2(v[j][2] * r * g[2], v[j][3] * r * g[3])}; p8[64 * j] = a;
        u32x2 c = {pk2(w[j][0] * q * g[0], w[j][1] * q * g[1]), pk2(w[j][2] * q * g[2], w[j][3] * q * g[3])}; q8[64 * j] = c; }
}
DI void p0_prologue(const Params& p, LAS unsigned char* L) {
    const int tid = threadIdx.x, lane = tid & 63, wave = tid >> 6;
    LAS float* scr = (LAS float*)(L + wave * 16384);
    const int gw = blockIdx.x * 8 + wave, NGW = gridDim.x * 8;
    unsigned char* ws = p.ws;
    constexpr int I_IN = 16 * 88, I_KV = 16 * 64, I_SQ = 16 * 32, I_GU = 16 * 176, I_DN = 44 * 32;
    constexpr int NIT = I_IN + I_KV + 3 * I_SQ + I_GU + I_DN;
    for (int it = gw; it < NIT; it += NGW) {
        int r = it;
        if (r < I_IN) { p0_transpose_item<0>(p.w_in, DM, INC, nullptr, (bf16_t*)(ws + WS_WIN), scr, r, lane); continue; } r -= I_IN;
        if (r < I_KV) { p0_transpose_item<0>(p.w_xkv, DM, 2048, nullptr, (bf16_t*)(ws + WS_WIN) + (size_t)INC * DM, scr, r, lane); continue; } r -= I_KV;
        if (r < I_SQ) { p0_transpose_item<0>(p.w_out, DM, DM, nullptr, (bf16_t*)(ws + WS_WOUT), scr, r, lane); continue; } r -= I_SQ;
        if (r < I_SQ) { p0_transpose_item<0>(p.w_xq, DM, DM, p.norm_xattn, (bf16_t*)(ws + WS_WXQ), scr, r, lane); continue; } r -= I_SQ;
        if (r < I_SQ) { p0_transpose_item<0>(p.w_xo, DM, DM, nullptr, (bf16_t*)(ws + WS_WXO), scr, r, lane); continue; } r -= I_SQ;
        if (r < I_GU) { p0_transpose_item<1>(p.w_gu, DM, 2 * FFH, p.norm_ffn, (bf16_t*)(ws + WS_WGU), scr, r, lane); continue; } r -= I_GU;
        p0_transpose_item<0>(p.w_down, FFH, DM, nullptr, (bf16_t*)(ws + WS_WDN), scr, r, lane);
    }
    bf16_t* xb = (bf16_t*)(ws + WS_XB);
    for (int m = 2 * gw; m < NTOK + NMEM; m += 2 * NGW) {
        if (m < NTOK) rms_rows2_to_bf16(p.x + (size_t)m * DM, p.x + (size_t)(m + 1) * DM, p.norm_mix, xb + (size_t)m * DM, xb + (size_t)(m + 1) * DM, lane);
        else rms_rows2_to_bf16(p.mem + (size_t)(m - NTOK) * DM, p.mem + (size_t)(m + 1 - NTOK) * DM, p.norm_mem, xb + (size_t)m * DM, xb + (size_t)(m + 1) * DM, lane);
    }
}

struct HgIn { unsigned z[16]; unsigned vv[8]; unsigned q[16]; u32x4 st[4]; };
template <bool PHC> DI void hg_load(const Params& p, int unit, HgIn& in) {
    const int tid = threadIdx.x, d = tid & 127, qt = tid >> 7;
    const int bh = unit >> 5, c = unit & 31, b = bh >> 2, h = bh & 3;
    const bf16_t* base = (const bf16_t*)(p.ws + WS_PROJ) + ((size_t)b * SEQ + c * 64 + 16 * qt) * INC + h * 128 + d;
#pragma unroll
    for (int i = 0; i < 16; ++i) in.z[i] = base[(size_t)i * INC + 1280];
#pragma unroll
    for (int i = 0; i < 8; ++i) in.vv[i] = (unsigned)base[(size_t)(2 * i) * INC + 1792] | ((unsigned)base[(size_t)(2 * i + 1) * INC + 1792] << 16);
    if (PHC) {
#pragma unroll
        for (int i = 0; i < 16; ++i) in.q[i] = base[(size_t)i * INC + 768];
        const bf16_t* Sst = (const bf16_t*)(p.ws + WS_XQ) + (size_t)unit * 16384;
#pragma unroll
        for (int i = 0; i < 4; ++i) { const int ch = tid + 512 * i; in.st[i] = *(const u32x4*)(Sst + (size_t)(ch >> 4) * 128 + (ch & 15) * 8); }
    }
}
DI void hgrn_a_unit(const Params& p, LAS unsigned char* L, int unit, const HgIn& in) {
    const int tid = threadIdx.x, lane = tid & 63, wid = tid >> 6, fr = lane & 15, fq = lane >> 4;
    const int bh = unit >> 5, h = bh & 3;
    bf16_t* DT = (bf16_t*)(p.ws + WS_XQ) + (size_t)unit * 16384;
    float* decay = (float*)(p.ws + WS_DECAY) + (size_t)unit * 128;
    LAS float* part = (LAS float*)L;
    LAS unsigned char* KhT = L + 2048;
    LAS unsigned char* VT = L + 2048 + 18432;
    const int d = tid & 127, qt = tid >> 7;
    const float lbv = sigmoidf_(p.lb_logits[h * 128 + d] - p.lb_logits[512 + h * 128 + d]);
    float bc[16], kk[16]; float run = 0.f;
#pragma unroll
    for (int i = 0; i < 16; ++i) { const float z = bf2f(in.z[i]); const float f = lbv + (1.f - lbv) * sigmoidf_(z); run += __logf(f); bc[i] = run; kk[i] = 1.f - f; }
    part[qt * 128 + d] = run;
    { u32x4 w0 = {in.vv[0], in.vv[1], in.vv[2], in.vv[3]}, w1 = {in.vv[4], in.vv[5], in.vv[6], in.vv[7]};
      *(LAS u32x4*)(VT + d * 144 + qt * 32) = w0; *(LAS u32x4*)(VT + d * 144 + qt * 32 + 16) = w1; }
    __syncthreads();
    float off = 0.f, tot = 0.f;
#pragma unroll
    for (int q = 0; q < 4; ++q) { const float v = part[q * 128 + d]; tot += v; if (q < qt) off += v; }
    { unsigned kw[8];
#pragma unroll
      for (int i = 0; i < 8; ++i) { const float a0 = kk[2 * i] * __expf(tot - (off + bc[2 * i])), a1 = kk[2 * i + 1] * __expf(tot - (off + bc[2 * i + 1])); kw[i] = pk2(a0, a1); }
      u32x4 w0 = {kw[0], kw[1], kw[2], kw[3]}, w1 = {kw[4], kw[5], kw[6], kw[7]};
      *(LAS u32x4*)(KhT + d * 144 + qt * 32) = w0; *(LAS u32x4*)(KhT + d * 144 + qt * 32 + 16) = w1; }
    if (qt == 0) decay[d] = __expf(tot);
    __syncthreads();
    bf16x8 a[2];
#pragma unroll
    for (int ks = 0; ks < 2; ++ks) a[ks] = lds_frag(KhT + (16 * wid + fr) * 144 + (32 * ks + 8 * fq) * 2);
#pragma unroll
    for (int et = 0; et < 8; ++et) { f32x4 acc = {0.f, 0.f, 0.f, 0.f};
#pragma unroll
        for (int ks = 0; ks < 2; ++ks) acc = MFMA16(a[ks], lds_frag(VT + (16 * et + fr) * 144 + (32 * ks + 8 * fq) * 2), acc);
        u32x2 w = {pk2(acc[0], acc[1]), pk2(acc[2], acc[3])};
        *(u32x2*)(DT + (size_t)(16 * et + fr) * 128 + 16 * wid + 4 * fq) = w; }
    __syncthreads();
}
DI void hgrn_scan(const Params& p) {
    bf16_t* DT = (bf16_t*)(p.ws + WS_XQ); const float* decay = (const float*)(p.ws + WS_DECAY);
    for (int gid = blockIdx.x * 512 + threadIdx.x; gid < 32 * 4096; gid += gridDim.x * 512) {
        const int bh = gid >> 12, rem = gid & 4095, e = rem >> 5, d4 = (rem & 31) * 4;
        f32x4 S = {0.f, 0.f, 0.f, 0.f};
#pragma unroll 1
        for (int c0 = 0; c0 < 32; c0 += 8) { u32x2 raw[8]; f32x4 a[8];
#pragma unroll
            for (int k = 0; k < 8; ++k) { raw[k] = *(const u32x2*)(DT + ((size_t)(bh * 32 + c0 + k) * 128 + e) * 128 + d4); a[k] = *(const f32x4*)(decay + (size_t)(bh * 32 + c0 + k) * 128 + d4); }
#pragma unroll
            for (int k = 0; k < 8; ++k) { u32x2 w = {pk2(S[0], S[1]), pk2(S[2], S[3])}; *(u32x2*)(DT + ((size_t)(bh * 32 + c0 + k) * 128 + e) * 128 + d4) = w;
                S[0] = a[k][0] * S[0] + lo_f(raw[k].x); S[1] = a[k][1] * S[1] + hi_f(raw[k].x); S[2] = a[k][2] * S[2] + lo_f(raw[k].y); S[3] = a[k][3] * S[3] + hi_f(raw[k].y); } }
    }
}
DI void hgrn_c_unit(const Params& p, LAS unsigned char* L, int unit, const HgIn& in) {
    const int tid = threadIdx.x, lane = tid & 63, wid = tid >> 6, fr = lane & 15, fq = lane >> 4;
    const int bh = unit >> 5, c = unit & 31, b = bh >> 2, h = bh & 3;
    const size_t tok0 = (size_t)b * SEQ + c * 64;
    const bf16_t* proj = (const bf16_t*)(p.ws + WS_PROJ);
    bf16_t* mix = (bf16_t*)(p.ws + WS_MIX);
    LAS float* part = (LAS float*)L;
    LAS float* exch = (LAS float*)(L + 2048);
    LAS unsigned char* Qh = L + 4096;
    LAS unsigned char* Qc = Qh + 17408;
    LAS unsigned char* Kh = Qc + 17408;
    LAS unsigned char* VT = Kh + 17408;
    LAS unsigned char* ST = VT + 18432;
    const int d = tid & 127, qt = tid >> 7;
    const int tt = wid & 3, eh = wid >> 2;
    const size_t row = tok0 + 16 * tt + fr;
    u32x2 gw[4];
#pragma unroll
    for (int et = 0; et < 4; ++et) gw[et] = *(const u32x2*)(proj + row * INC + 2304 + h * 128 + 16 * (4 * eh + et) + 4 * fq);
    const float lbv = sigmoidf_(p.lb_logits[h * 128 + d] - p.lb_logits[512 + h * 128 + d]);
    float bc[16], kk[16], qs[16]; float run = 0.f;
#pragma unroll
    for (int i = 0; i < 16; ++i) { const float z = bf2f(in.z[i]); const float f = lbv + (1.f - lbv) * sigmoidf_(z); run += __logf(f); bc[i] = run; kk[i] = 1.f - f;
        const float qv = bf2f(in.q[i]); qs[i] = qv * sigmoidf_(qv); }
    part[qt * 128 + d] = run;
    { u32x4 w0 = {in.vv[0], in.vv[1], in.vv[2], in.vv[3]}, w1 = {in.vv[4], in.vv[5], in.vv[6], in.vv[7]};
      *(LAS u32x4*)(VT + d * 144 + qt * 32) = w0; *(LAS u32x4*)(VT + d * 144 + qt * 32 + 16) = w1; }
#pragma unroll
    for (int i = 0; i < 4; ++i) { const int ch = tid + 512 * i, e = ch >> 4, cc = ch & 15; *(LAS u32x4*)(ST + e * 272 + cc * 16) = in.st[i]; }
    __syncthreads();
    { const float p0 = part[d], p1 = part[128 + d], p2 = part[256 + d]; const float bmid = p0 + p1; const float off = qt == 0 ? 0.f : qt == 1 ? p0 : qt == 2 ? p0 + p1 : p0 + p1 + p2;
#pragma unroll
      for (int i = 0; i < 16; ++i) { const float bt = off + bc[i]; const int t = 16 * qt + i;
          *(LAS bf16_t*)(Qh + t * 272 + d * 2) = (bf16_t)pk2(qs[i] * __expf(bt - bmid), 0.f);
          *(LAS bf16_t*)(Qc + t * 272 + d * 2) = (bf16_t)pk2(qs[i] * __expf(bt), 0.f);
          *(LAS bf16_t*)(Kh + t * 272 + d * 2) = (bf16_t)pk2(kk[i] * __expf(bmid - bt), 0.f); } }
    __syncthreads();
    bf16x8 qf[4];
#pragma unroll
    for (int ks = 0; ks < 4; ++ks) qf[ks] = lds_frag(Qh + (16 * tt + fr) * 272 + (32 * ks + 8 * fq) * 2);
    f32x4 st[4];
#pragma unroll
    for (int kt = 0; kt < 4; ++kt) { st[kt] = (f32x4){0.f, 0.f, 0.f, 0.f};
        if (kt <= tt) {
#pragma unroll
            for (int ks = 0; ks < 4; ++ks) st[kt] = MFMA16(lds_frag(Kh + (16 * kt + fr) * 272 + (32 * ks + 8 * fq) * 2), qf[ks], st[kt]);
#pragma unroll
            for (int v = 0; v < 4; ++v) if (16 * kt + 4 * fq + v > 16 * tt + fr) st[kt][v] = 0.f;
        } }
    bf16x8 pk[2]; pk[0] = pack8(st[0], st[1]); pk[1] = pack8(st[2], st[3]);
#pragma unroll
    for (int ks = 0; ks < 4; ++ks) qf[ks] = lds_frag(Qc + (16 * tt + fr) * 272 + (32 * ks + 8 * fq) * 2);
    f32x4 o[4]; float ss = 0.f;
#pragma unroll
    for (int et = 0; et < 4; ++et) { const int e = 16 * (4 * eh + et) + fr; f32x4 acc = {0.f, 0.f, 0.f, 0.f};
#pragma unroll
        for (int s2 = 0; s2 < 2; ++s2) if (2 * s2 <= tt) acc = MFMA16(lds_frag2(VT + e * 144 + (32 * s2 + 4 * fq) * 2, VT + e * 144 + (32 * s2 + 16 + 4 * fq) * 2), pk[s2], acc);
#pragma unroll
        for (int ks = 0; ks < 4; ++ks) acc = MFMA16(lds_frag(ST + e * 272 + (32 * ks + 8 * fq) * 2), qf[ks], acc);
        o[et] = acc; ss += (acc[0] * acc[0] + acc[1] * acc[1]) + (acc[2] * acc[2] + acc[3] * acc[3]); }
    ss += __shfl_xor(ss, 16); ss += __shfl_xor(ss, 32);
    if (fq == 0) exch[eh * 64 + 16 * tt + fr] = ss;
    __syncthreads();
    const float rs = __builtin_amdgcn_rsqf((exch[16 * tt + fr] + exch[64 + 16 * tt + fr]) * (1.f / 128.f) + EPS);
#pragma unroll
    for (int et = 0; et < 4; ++et) { const int e0 = 16 * (4 * eh + et) + 4 * fq; const f32x4 gn = *(const f32x4*)(p.hg_gain + h * 128 + e0);
        const float g0 = lo_f(gw[et].x), g1 = hi_f(gw[et].x), g2 = lo_f(gw[et].y), g3 = hi_f(gw[et].y);
        u32x2 w = {pk2(o[et][0] * rs * gn[0] * g0 * sigmoidf_(g0), o[et][1] * rs * gn[1] * g1 * sigmoidf_(g1)), pk2(o[et][2] * rs * gn[2] * g2 * sigmoidf_(g2), o[et][3] * rs * gn[3] * g3 * sigmoidf_(g3))};
        *(u32x2*)(mix + row * DM + 512 + h * 128 + e0) = w; }
    __syncthreads();
}
template <bool PHC> DI void hgrn_phase(const Params& p, LAS unsigned char* L) {
    const int G = gridDim.x; int u = blockIdx.x; if (u >= 1024) return;
    HgIn A, B; hg_load<PHC>(p, u, A);
    for (;;) {
        if (u + G < 1024) hg_load<PHC>(p, u + G, B);
        if (PHC) hgrn_c_unit(p, L, u, A); else hgrn_a_unit(p, L, u, A);
        u += G; if (u >= 1024) break;
        if (u + G < 1024) hg_load<PHC>(p, u + G, A);
        if (PHC) hgrn_c_unit(p, L, u, B); else hgrn_a_unit(p, L, u, B);
        u += G; if (u >= 1024) break;
    }
}

#define ROT_REV(j) ((j) == 0 ? 0.15915494309189535 : (j) == 1 ? 0.03086376340470123 : (j) == 2 ? 0.005985185712713705 : (j) == 3 ? 0.001160663641240061 : (j) == 4 ? 0.00022507907903927653 : (j) == 5 ? 4.364795279280289e-05 : (j) == 6 ? 8.464330808241401e-06 : 1.6414262627950345e-06)
DI void rot_cs(int pos, double rv, float& c, float& s) { double r = (double)pos * rv; r -= __builtin_floor(r); const float f = (float)r; s = __builtin_amdgcn_sinf(f); c = __builtin_amdgcn_cosf(f); }
DI void swa_unit(const Params& p, LAS unsigned char* L, int unit) {
    const int tid = threadIdx.x, lane = tid & 63, wid = tid >> 6, fr = lane & 15, fq = lane >> 4;
    const int b = unit >> 5, j = unit & 31, t0 = 64 * j, ws0 = t0 - 128; const size_t tokbase = (size_t)b * SEQ;
    const bf16_t* proj = (const bf16_t*)(p.ws + WS_PROJ);
    bf16_t* mix = (bf16_t*)(p.ws + WS_MIX);
    LAS unsigned char* Kl = L;
    LAS unsigned char* VT = L + 52224;
    LAS float* exch = (LAS float*)(L + 52224 + 51200);
#pragma unroll 1
    for (int item = tid; item < 1536; item += 512) { const int s = item >> 3, c16 = item & 7, ta = ws0 + s; LAS unsigned char* dst = Kl + s * 272 + c16 * 32;
        u32x4 v0 = {0u, 0u, 0u, 0u}, v1 = {0u, 0u, 0u, 0u};
        if (ta >= 0) { const bf16_t* src = proj + (tokbase + ta) * INC + 512 + c16 * 16; v0 = *(const u32x4*)src; v1 = *(const u32x4*)(src + 8);
            if ((c16 & 3) == 0) { const int pos = p.pos[tokbase + ta]; unsigned o1[4], o2[4];
#pragma unroll
                for (int jj = 0; jj < 4; ++jj) { float c0, s0, c1, s1; rot_cs(pos, ROT_REV(2 * jj), c0, s0); rot_cs(pos, ROT_REV(2 * jj + 1), c1, s1);
                    const float a0 = lo_f(v0[jj]), a1 = hi_f(v0[jj]), b0 = lo_f(v1[jj]), b1 = hi_f(v1[jj]);
                    o1[jj] = pk2(a0 * c0 - b0 * s0, a1 * c1 - b1 * s1); o2[jj] = pk2(b0 * c0 + a0 * s0, b1 * c1 + a1 * s1); }
                v0 = (u32x4){o1[0], o1[1], o1[2], o1[3]}; v1 = (u32x4){o2[0], o2[1], o2[2], o2[3]}; } }
        *(LAS u32x4*)dst = v0; *(LAS u32x4*)(dst + 16) = v1; }
    { const int ch = tid & 127, kq = tid >> 7;
#pragma unroll 1
      for (int g0 = 0; g0 < 6; g0 += 3) { unsigned vv[12];
#pragma unroll
          for (int i = 0; i < 12; ++i) { const int ta = ws0 + 48 * kq + 8 * g0 + 2 * i; unsigned lo = 0u, hi = 0u;
              if (ta >= 0) { lo = proj[(tokbase + ta) * INC + 640 + ch]; hi = proj[(tokbase + ta + 1) * INC + 640 + ch]; }
              vv[i] = lo | (hi << 16); }
#pragma unroll
          for (int k = 0; k < 3; ++k) { u32x4 w = {vv[4 * k], vv[4 * k + 1], vv[4 * k + 2], vv[4 * k + 3]}; *(LAS u32x4*)(VT + ch * 400 + kq * 96 + (g0 + k) * 16) = w; } } }
    __syncthreads();
    const int tt = wid & 3, hk = wid >> 2; const size_t row = tokbase + t0 + 16 * tt + fr;
    float cq[8], sq[8];
    { const int pos = p.pos[row];
#pragma unroll
      for (int jj = 0; jj < 8; ++jj) rot_cs(pos, ROT_REV(jj), cq[jj], sq[jj]); }
    f32x4 o[4][4]; float ss = 0.f;
#pragma unroll
    for (int hh = 0; hh < 4; ++hh) { const int head = 4 * hk + hh;
        bf16x8 qb[2];
#pragma unroll
        for (int ks = 0; ks < 2; ++ks) { const u32x4 raw = *(const u32x4*)(proj + row * INC + head * 64 + 32 * ks + 8 * fq); float q[8];
#pragma unroll
            for (int e = 0; e < 4; ++e) { q[2 * e] = lo_f(raw[e]); q[2 * e + 1] = hi_f(raw[e]); }
            if (ks == 0) {
#pragma unroll
                for (int e = 0; e < 8; ++e) { const float pr = __shfl_xor(q[e], 16); const float r0 = q[e] * cq[e] - pr * sq[e], r1 = q[e] * cq[e] + pr * sq[e]; q[e] = fq == 0 ? r0 : fq == 1 ? r1 : q[e]; } }
            const float sc = 0.125f * LOG2E;
            u32x4 w = {pk2(q[0] * sc, q[1] * sc), pk2(q[2] * sc, q[3] * sc), pk2(q[4] * sc, q[5] * sc), pk2(q[6] * sc, q[7] * sc)}; qb[ks] = __builtin_bit_cast(bf16x8, w); }
        f32x4 st[9];
#pragma unroll
        for (int k9 = 0; k9 < 9; ++k9) { f32x4 acc = {0.f, 0.f, 0.f, 0.f};
#pragma unroll
            for (int ks = 0; ks < 2; ++ks) acc = MFMA16(lds_frag(Kl + (16 * (tt + k9) + fr) * 272 + (hk * 64 + 32 * ks + 8 * fq) * 2), qb[ks], acc);
            st[k9] = acc; }
        const float sinkl = p.sinks[head] * LOG2E; float mx = sinkl;
#pragma unroll
        for (int k9 = 0; k9 < 9; ++k9)
#pragma unroll
            for (int v = 0; v < 4; ++v) { const int s1 = 16 * k9 + 4 * fq + v; const bool ok = (s1 > fr) && (s1 <= fr + 128) && (ws0 + 16 * tt + s1 >= 0);
                st[k9][v] = ok ? st[k9][v] : -INFINITY; mx = fmaxf(mx, st[k9][v]); }
        mx = fmaxf(mx, __shfl_xor(mx, 16)); mx = fmaxf(mx, __shfl_xor(mx, 32));
        float l = 0.f;
#pragma unroll
        for (int k9 = 0; k9 < 9; ++k9)
#pragma unroll
            for (int v = 0; v < 4; ++v) { const float e = __builtin_amdgcn_exp2f(st[k9][v] - mx); st[k9][v] = e; l += e; }
        l += __shfl_xor(l, 16); l += __shfl_xor(l, 32); l += __builtin_amdgcn_exp2f(sinkl - mx);
        const float rl = __builtin_amdgcn_rcpf(l);
        bf16x8 pk[5];
#pragma unroll
        for (int s2 = 0; s2 < 4; ++s2) pk[s2] = pack8(st[2 * s2], st[2 * s2 + 1]);
        pk[4] = pack8(st[8], (f32x4){0.f, 0.f, 0.f, 0.f});
#pragma unroll
        for (int dt = 0; dt < 4; ++dt) { const LAS unsigned char* vr = VT + (hk * 64 + 16 * dt + fr) * 400 + (16 * tt + 4 * fq) * 2; f32x4 acc = {0.f, 0.f, 0.f, 0.f};
#pragma unroll
            for (int s2 = 0; s2 < 4; ++s2) acc = MFMA16(lds_frag2(vr + s2 * 64, vr + s2 * 64 + 32), pk[s2], acc);
            acc = MFMA16(lds_frag_lo(vr + 256), pk[4], acc);
            acc = acc * rl; o[hh][dt] = acc; ss += (acc[0] * acc[0] + acc[1] * acc[1]) + (acc[2] * acc[2] + acc[3] * acc[3]); }
        __builtin_amdgcn_sched_barrier(0); }
    ss += __shfl_xor(ss, 16); ss += __shfl_xor(ss, 32);
    if (fq == 0) exch[hk * 64 + 16 * tt + fr] = ss;
    __syncthreads();
    const float rs = __builtin_amdgcn_rsqf((exch[16 * tt + fr] + exch[64 + 16 * tt + fr]) * (1.f / 512.f) + EPS);
#pragma unroll
    for (int hh = 0; hh < 4; ++hh)
#pragma unroll
        for (int dt = 0; dt < 4; ++dt) { const int ch = (4 * hk + hh) * 64 + 16 * dt + 4 * fq; const f32x4 gn = *(const f32x4*)(p.att_gain + ch); const f32x4 a = o[hh][dt];
            u32x2 w = {pk2(a[0] * rs * gn[0], a[1] * rs * gn[1]), pk2(a[2] * rs * gn[2], a[3] * rs * gn[3])}; *(u32x2*)(mix + row * DM + ch) = w; }
    __syncthreads();
}

DI void xattn_unit(const Params& p, LAS unsigned char* L, int unit) {
    const int tid = threadIdx.x, lane = tid & 63, wid = tid >> 6, fr = lane & 15, fq = lane >> 4;
    const int b = unit >> 5, h = (unit >> 3) & 3, qb = unit & 7;
    const bf16_t* xq = (const bf16_t*)(p.ws + WS_XQ); const bf16_t* xkv = (const bf16_t*)(p.ws + WS_XKV); bf16_t* xo = (bf16_t*)(p.ws + WS_MIX);
    const size_t row0 = (size_t)b * SEQ + qb * 256 + wid * 32 + fr;
    LAS unsigned char* B0 = L; LAS unsigned char* B1 = L + 67584;
    const bf16_t* kbase = xkv + (size_t)(b * 256) * 2048 + h * 256;
    const bf16_t* vt = xkv + (WS_XVT - WS_XKV) / 2 + (size_t)(b * 4 + h) * 65536;
    { u32x4 kreg[16];
#pragma unroll
      for (int i = 0; i < 16; ++i) { const int ch = tid + 512 * i, key = ch >> 5, cc = ch & 31; kreg[i] = *(const u32x4*)(kbase + (size_t)key * 2048 + cc * 8); }
#pragma unroll
      for (int i = 0; i < 16; ++i) { const int ch = tid + 512 * i, key = ch >> 5, cc = ch & 31; *(LAS u32x4*)((key < 128 ? B0 : B1) + (key & 127) * 528 + cc * 16) = kreg[i]; } }
    u32x4 vreg[8];
#pragma unroll
    for (int i = 0; i < 8; ++i) { const int ch = tid + 512 * i, dd = ch >> 5, cc = ch & 31; vreg[i] = *(const u32x4*)(vt + (size_t)dd * 256 + cc * 8); }
    __syncthreads();
    bf16x8 pk[2][8]; float rl[2];
#pragma unroll
    for (int t = 0; t < 2; ++t) {
        bf16x8 qf[8];
#pragma unroll
        for (int ks = 0; ks < 8; ++ks) { const u32x4 raw = *(const u32x4*)(xq + (row0 + 16 * t) * DM + h * 256 + 32 * ks + 8 * fq); qf[ks] = __builtin_bit_cast(bf16x8, raw); }
        f32x4 st[16];
#pragma unroll
        for (int kt = 0; kt < 16; ++kt) { const LAS unsigned char* kr = (kt < 8 ? B0 : B1) + (16 * (kt & 7) + fr) * 528 + 8 * fq * 2; f32x4 acc = {0.f, 0.f, 0.f, 0.f};
#pragma unroll
            for (int ks = 0; ks < 8; ++ks) acc = MFMA16(lds_frag(kr + ks * 64), qf[ks], acc);
            st[kt] = acc; if (kt & 1) __builtin_amdgcn_sched_barrier(0); }
        float mx = -INFINITY;
#pragma unroll
        for (int kt = 0; kt < 16; ++kt)
#pragma unroll
            for (int v = 0; v < 4; ++v) mx = fmaxf(mx, st[kt][v]);
        mx = fmaxf(mx, __shfl_xor(mx, 16)); mx = fmaxf(mx, __shfl_xor(mx, 32));
        float l = 0.f;
#pragma unroll
        for (int kt = 0; kt < 16; ++kt)
#pragma unroll
            for (int v = 0; v < 4; ++v) { const float e = __builtin_amdgcn_exp2f(st[kt][v] - mx); st[kt][v] = e; l += e; }
        l += __shfl_xor(l, 16); l += __shfl_xor(l, 32);
        rl[t] = __builtin_amdgcn_rcpf(l);
#pragma unroll
        for (int s2 = 0; s2 < 8; ++s2) pk[t][s2] = pack8(st[2 * s2], st[2 * s2 + 1]);
        __builtin_amdgcn_sched_barrier(0);
    }
    __syncthreads();
    { u32x4 v2[8];
#pragma unroll
      for (int i = 0; i < 8; ++i) { const int ch = tid + 512 * (i + 8), dd = ch >> 5, cc = ch & 31; v2[i] = *(const u32x4*)(vt + (size_t)dd * 256 + cc * 8); }
#pragma unroll
      for (int i = 0; i < 8; ++i) { const int ch = tid + 512 * i, dd = ch >> 5, cc = ch & 31; *(LAS u32x4*)(B0 + dd * 528 + cc * 16) = vreg[i]; }
#pragma unroll
      for (int i = 0; i < 8; ++i) { const int ch = tid + 512 * (i + 8), dd = ch >> 5, cc = ch & 31; *(LAS u32x4*)(B1 + (dd & 127) * 528 + cc * 16) = v2[i]; } }
    __syncthreads();
#pragma unroll 1
    for (int hf = 0; hf < 2; ++hf)
#pragma unroll 1
        for (int dg = 0; dg < 2; ++dg) { f32x4 a0[4], a1[4];
#pragma unroll
            for (int i = 0; i < 4; ++i) { a0[i] = (f32x4){0.f, 0.f, 0.f, 0.f}; a1[i] = (f32x4){0.f, 0.f, 0.f, 0.f}; }
#pragma unroll
            for (int s2 = 0; s2 < 8; ++s2)
#pragma unroll
                for (int i = 0; i < 4; ++i) { const LAS unsigned char* vr = (hf ? B1 : B0) + (16 * (4 * dg + i) + fr) * 528 + (32 * s2 + 4 * fq) * 2; const bf16x8 vf = lds_frag2(vr, vr + 32);
                    a0[i] = MFMA16(vf, pk[0][s2], a0[i]); a1[i] = MFMA16(vf, pk[1][s2], a1[i]); }
#pragma unroll
            for (int i = 0; i < 4; ++i) { const f32x4 x0 = a0[i] * rl[0], x1 = a1[i] * rl[1]; u32x2 w0 = {pk2(x0[0], x0[1]), pk2(x0[2], x0[3])}, w1 = {pk2(x1[0], x1[1]), pk2(x1[2], x1[3])};
                bf16_t* dst = xo + row0 * DM + h * 256 + hf * 128 + 16 * (4 * dg + i) + 4 * fq; *(u32x2*)dst = w0; *(u32x2*)(dst + 16 * DM) = w1; } }
    __syncthreads();
}

DI void final_norm(const Params& p) {
    const int lane = threadIdx.x & 63, wave = threadIdx.x >> 6;
    for (int m = blockIdx.x * 8 + wave; m < NTOK; m += gridDim.x * 8) {
        f32x4* xr = (f32x4*)(p.out + (size_t)m * DM) + lane; const f32x4* gr = (const f32x4*)p.norm_final + lane;
        f32x4 v[4]; float s = 0.f;
#pragma unroll
        for (int j = 0; j < 4; ++j) { v[j] = xr[64 * j]; s += (v[j][0] * v[j][0] + v[j][1] * v[j][1]) + (v[j][2] * v[j][2] + v[j][3] * v[j][3]); }
        const float r = __builtin_amdgcn_rsqf(wave_sum(s) * (1.f / DM) + EPS);
#pragma unroll
        for (int j = 0; j < 4; ++j) xr[64 * j] = v[j] * r * gr[64 * j];
    }
}

constexpr int N_PHASES = 12;
#ifndef REP_MASK
#define REP_MASK 0
#endif
#ifndef SKIP_MASK
#define SKIP_MASK 0
#endif
#ifndef TS_PROBE
#define TS_PROBE 0
#define TS_A 0
#define TS_B 0
#endif
constexpr size_t WS_TS = 2 * MiB + 768 * 1024;
template <int PASS> DI void run_program(const Params& p, LAS unsigned char* L, cg::grid_group& grid) {
    unsigned char* ws = p.ws;
    const int lo = p.ph_lo, hi = p.ph_hi, G = gridDim.x, bid = blockIdx.x;
#define IN(k) (lo <= (k) && (k) < hi && !(PASS == 0 && ((SKIP_MASK >> (k)) & 1)))
#define SEAM(k) do { if ((k) != 7 && lo <= (k) && (k) + 1 < hi) grid.sync(); if (TS_PROBE && PASS == 1 && bid == 0 && threadIdx.x == 0) ((unsigned long long*)(ws + WS_TS))[(k) + 1] = __builtin_amdgcn_s_memrealtime(); } while (0)
    bf16_t* const xb = (bf16_t*)(ws + WS_XB); bf16_t* const proj = (bf16_t*)(ws + WS_PROJ); bf16_t* const mix = (bf16_t*)(ws + WS_MIX); bf16_t* const xq = (bf16_t*)(ws + WS_XQ);
    float* const part1 = (float*)(ws + WS_PART1); float* const part2 = (float*)(ws + WS_PART2);

    if (TS_PROBE && PASS == 1 && bid == 0 && threadIdx.x == 0) ((unsigned long long*)(ws + WS_TS))[0] = __builtin_amdgcn_s_memrealtime();
    if (IN(0)) { p0_prologue(p, L); } SEAM(0);
    if (IN(1)) { pg8::Gemm g{xb, (const bf16_t*)(ws + WS_WIN), NTOK + NMEM, INC + 2048, DM}; OrderP1 S{G, bid}; EpiProj E{proj, (bf16_t*)(ws + WS_XKV)};
        pg8::gemm_phase<EpiProj, OrderP1, true, true>(L, g, S, E); } SEAM(1);
    if (IN(2)) { hgrn_phase<false>(p, L); } SEAM(2);
    if (IN(3)) { hgrn_scan(p); for (int rep = 0; rep < 1 + ((REP_MASK >> 3) & 1); ++rep) for (int u = bid; u < 256; u += G) swa_unit(p, L, u); } SEAM(3);
    if (IN(4)) { hgrn_phase<true>(p, L); } SEAM(4);
    if (IN(5)) { pg8::Gemm g{mix, (const bf16_t*)(ws + WS_WOUT), NTOK, DM, DM}; pg8::StaticOrder S; S.init(NTOK, DM, G, bid); EpiRes<0> E{p.x, xb, part1};
        pg8::gemm_phase<EpiRes<0>, pg8::StaticOrder, true, true>(L, g, S, E); } SEAM(5);
    if (IN(6)) { pg8::Gemm g{xb, (const bf16_t*)(ws + WS_WXQ), NTOK, DM, DM}; pg8::StaticOrder S; S.init(NTOK, DM, G, bid); EpiScale E{xq, part1, 0.0625f * LOG2E};
        pg8::gemm_phase<EpiScale, pg8::StaticOrder, true, true>(L, g, S, E);
        asm volatile("s_waitcnt vmcnt(0)" ::: "memory"); __syncthreads();
        Unit u; for (int i = 0; S.next(i, u); ++i) xattn_unit(p, L, (u.pm >> 3) * 32 + u.pn * 8 + (u.pm & 7)); } SEAM(6);
    if (IN(7)) { } SEAM(7);
    if (IN(8)) { pg8::Gemm g{mix, (const bf16_t*)(ws + WS_WXO), NTOK, DM, DM}; pg8::StaticOrder S; S.init(NTOK, DM, G, bid); EpiRes<1> E{xb, xb, part2};
        pg8::gemm_phase<EpiRes<1>, pg8::StaticOrder, true, true>(L, g, S, E); } SEAM(8);
    if (IN(9)) { pg8::Gemm g{xb, (const bf16_t*)(ws + WS_WGU), NTOK, 2 * FFH, DM}; pg8::StaticOrder S; S.init(NTOK, 2 * FFH, G, bid); EpiSwiGLU E{proj, part2};
        pg8::gemm_phase<EpiSwiGLU, pg8::StaticOrder, true, true>(L, g, S, E); } SEAM(9);
    if (IN(10)) { pg8::Gemm g{proj, (const bf16_t*)(ws + WS_WDN), NTOK, DM, FFH}; pg8::StaticOrder S; S.init(NTOK, DM, G, bid); EpiRes<2> E{xb, p.out, nullptr};
        pg8::gemm_phase<EpiRes<2>, pg8::StaticOrder, true, true>(L, g, S, E); } SEAM(10);
    if (IN(11)) { final_norm(p); } SEAM(11);
#undef IN
#undef SEAM
}
__global__ void __launch_bounds__(512, 2) fwd_kernel(Params p) {
    extern __shared__ __attribute__((aligned(16))) unsigned char lds_raw[];
    LAS unsigned char* L = (LAS unsigned char*)lds_raw;
    cg::grid_group grid = cg::this_grid();
#if SKIP_MASK
    run_program<0>(p, L, grid); grid.sync();
#endif
    run_program<1>(p, L, grid);
#if TS_PROBE
    grid.sync();
    if (threadIdx.x == 0) { const unsigned long long* ts = (const unsigned long long*)(p.ws + WS_TS); const unsigned long long dt = 9ull * (__hip_atomic_load(ts + TS_A + 1, __ATOMIC_RELAXED, __HIP_MEMORY_SCOPE_AGENT) - __hip_atomic_load(ts + TS_A, __ATOMIC_RELAXED, __HIP_MEMORY_SCOPE_AGENT));
        const unsigned long long t0 = __builtin_amdgcn_s_memrealtime(); if (dt < 200000ull) while (__builtin_amdgcn_s_memrealtime() - t0 < dt) __builtin_amdgcn_s_sleep(8); }
    __syncthreads();
#endif
}

extern "C" void kernel_launch(void* const* d_in, const int* in_sizes, int n_in, void* d_out, int out_size, void* d_ws, size_t ws_size, hipStream_t stream) {
    static int grid = 0;
    if (grid == 0) {
        int dev = 0, cus = 0, per_cu = 0;
        if (hipGetDevice(&dev) != hipSuccess || hipDeviceGetAttribute(&cus, hipDeviceAttributeMultiprocessorCount, dev) != hipSuccess) { fprintf(stderr, "kernel_launch: device query failed\n"); grid = -1; return; }
        if (hipFuncSetAttribute((const void*)fwd_kernel, hipFuncAttributeMaxDynamicSharedMemorySize, LDS_BYTES) != hipSuccess) { fprintf(stderr, "kernel_launch: hipFuncSetAttribute failed\n"); grid = -1; return; }
        if (hipOccupancyMaxActiveBlocksPerMultiprocessor(&per_cu, (const void*)fwd_kernel, 512, LDS_BYTES) != hipSuccess || per_cu < 1) { fprintf(stderr, "kernel_launch: occupancy query gave %d\n", per_cu); per_cu = 1; }
        (void)hipGetLastError();
        grid = cus * 1;
        if (ws_size < 236 * MiB) { fprintf(stderr, "kernel_launch: workspace too small (%zu)\n", ws_size); grid = -1; return; }
    }
    if (grid < 0) return;
    Params p{};
    p.x = (const float*)d_in[0]; p.mem = (const float*)d_in[1]; p.pos = (const int*)d_in[2]; p.norm_mix = (const float*)d_in[3]; p.w_in = (const float*)d_in[4];
    p.sinks = (const float*)d_in[5]; p.att_gain = (const float*)d_in[6]; p.lb_logits = (const float*)d_in[7]; p.hg_gain = (const float*)d_in[8]; p.w_out = (const float*)d_in[9];
    p.norm_xattn = (const float*)d_in[10]; p.norm_mem = (const float*)d_in[11]; p.w_xq = (const float*)d_in[12]; p.w_xkv = (const float*)d_in[13]; p.w_xo = (const float*)d_in[14];
    p.norm_ffn = (const float*)d_in[15]; p.w_gu = (const float*)d_in[16]; p.w_down = (const float*)d_in[17]; p.norm_final = (const float*)d_in[18];
    p.out = (float*)d_out; p.ws = (unsigned char*)d_ws;
#if ONE_LAUNCH
    p.ph_lo = 0; p.ph_hi = N_PHASES;
    void* args[] = {&p};
    hipError_t e = hipLaunchCooperativeKernel((const void*)fwd_kernel, dim3(grid), dim3(512), args, LDS_BYTES, stream);
    if (e != hipSuccess) fprintf(stderr, "kernel_launch: cooperative launch failed: %s (grid %d)\n", hipGetErrorString(e), grid);
#else
    for (int k = 0; k < N_PHASES; ++k) { p.ph_lo = k; p.ph_hi = k + 1; hipLaunchKernelGGL(fwd_kernel, dim3(grid), dim3(512), LDS_BYTES, stream, p); }
#endif
}
```
